# Optimizing an MI355X kernel written in HIP

```python
import math
import jax, jax.numpy as jnp
from jax import lax
import numpy as np

D_MODEL = 1024
BATCH = 4
SEQ = 4096
DEPTH = 2

N_EVEN = (DEPTH + 1) // 2
N_ODD = DEPTH // 2

RWKV_WIDTH = D_MODEL // 2
RWKV_HEAD_DIM = 64
RWKV_HEADS = RWKV_WIDTH // RWKV_HEAD_DIM
DECAY_LORA = 64
ICLR_LORA = 64
GATE_LORA = 128
GN_EPS = 64e-5
POOL_WINDOWS = (2, 4, 8, 16)
POOL_GROUPS = len(POOL_WINDOWS)
POOL_WIDTH = D_MODEL // 2
POOL_GROUP_DIM = POOL_WIDTH // POOL_GROUPS
SHIFT_WIDTH = 3 * RWKV_WIDTH + DECAY_LORA + ICLR_LORA + GATE_LORA
IN_WIDTH = SHIFT_WIDTH + POOL_WIDTH
SPLITS = (0, RWKV_WIDTH, 2 * RWKV_WIDTH, 3 * RWKV_WIDTH, 3 * RWKV_WIDTH + DECAY_LORA,
          3 * RWKV_WIDTH + DECAY_LORA + ICLR_LORA, SHIFT_WIDTH)
ATT_HEADS = 8
ATT_HEAD_DIM = D_MODEL // (2 * ATT_HEADS)
ATT_V_DIM = 2 * ATT_HEAD_DIM
ROPE_DIMS = ATT_HEAD_DIM // 4
ROPE_THETA = 500000.0
Q_BLOCK = 128
SUBLN_EPS = 1e-5
MOE_GROUPS = 4
MOE_EXPERTS_PER_GROUP = 8
MOE_EXPERTS = MOE_GROUPS * MOE_EXPERTS_PER_GROUP
MOE_TOP_K = 2
MOE_HIDDEN = D_MODEL // 2
MOE_BLOCK = 128
RMS_EPS = 1e-6

kernel_name = "hybrid_rwkv7_pool_diffattn_hmoe"


def _rmsnorm(x, g, eps):
    xf = x.astype(jnp.float32)
    y = xf * lax.rsqrt(jnp.mean(xf * xf, axis=-1, keepdims=True) + eps)
    return (y * g.astype(jnp.float32)).astype(x.dtype)


def _rwkv7_step(S, inp):
    r_t, w_t, k_t, v_t, kk_t, b_t = inp
    sa = jnp.einsum('bhij,bhj->bhi', S, kk_t)
    S = S * w_t[:, :, None, :] - sa[..., None] * b_t[:, :, None, :] + v_t[..., None] * k_t[:, :, None, :]
    return S, jnp.einsum('bhij,bhj->bhi', S, r_t)


def _rwkv_pool_mixer(h, w_in, mu, w0, w2, a0, a2, g2, k_k, k_a, r_k, ln_w, ln_b, w_pool, pool_scale, w_out):
    B, T, _ = h.shape
    f32 = jnp.float32
    H, N = RWKV_HEADS, RWKV_HEAD_DIM
    p = h @ w_in
    ps = p[..., :SHIFT_WIDTH].astype(f32)
    prev = jnp.pad(ps, ((0, 0), (1, 0), (0, 0)))[:, :-1]
    z = ps + (prev - ps) * mu.astype(f32)
    r, k, v, wd, ad, gd = (z[..., SPLITS[j]:SPLITS[j + 1]] for j in range(6))
    w_log = -jax.nn.softplus(-(w0.astype(f32) + jnp.tanh(wd) @ w2.astype(f32))) - 0.5
    decay = jnp.exp(-jnp.exp(w_log))
    a = jax.nn.sigmoid(a0.astype(f32) + ad @ a2.astype(f32))
    g = jax.nn.sigmoid(gd) @ g2.astype(f32)
    heads = lambda t: t.reshape(B, T, H, N)
    r, k, v, a, decay = heads(r), heads(k), heads(v), heads(a), heads(decay)
    kk = k * k_k.astype(f32).reshape(H, N)
    kk = kk / jnp.maximum(jnp.sqrt(jnp.sum(kk * kk, axis=-1, keepdims=True)), 1e-12)
    k = k * (1.0 + (a - 1.0) * k_a.astype(f32).reshape(H, N))
    sf = lambda t: jnp.moveaxis(t, 1, 0)
    S0 = jnp.zeros((B, H, N, N), f32)
    _, y = lax.scan(_rwkv7_step, S0, (sf(r), sf(decay), sf(k), sf(v), sf(kk), sf(kk * a)))
    y = jnp.moveaxis(y, 0, 1)
    mean = jnp.mean(y, axis=-1, keepdims=True)
    var = jnp.mean(jnp.square(y - mean), axis=-1, keepdims=True)
    y = (y - mean) * lax.rsqrt(var + GN_EPS)
    y = y * ln_w.astype(f32).reshape(H, N) + ln_b.astype(f32).reshape(H, N)
    y = y + jnp.sum(r * k * r_k.astype(f32), axis=-1, keepdims=True) * v
    y_a = y.reshape(B, T, RWKV_WIDTH) * g
    u = p[..., SHIFT_WIDTH:].astype(f32).reshape(B, T, POOL_GROUPS, POOL_GROUP_DIM)
    c = jnp.pad(jnp.cumsum(u, axis=1), ((0, 0), (1, 0), (0, 0), (0, 0)))
    t_idx = jnp.arange(T)
    means = []
    for gi, win in enumerate(POOL_WINDOWS):
        lo = jnp.maximum(t_idx + 1 - win, 0)
        cnt = (t_idx + 1 - lo).astype(f32)
        cg = c[:, :, gi]
        means.append((cg[:, 1:] - cg[:, lo]) / cnt[None, :, None])
    pooled = jnp.stack(means, axis=2)
    y_b = jnp.einsum('btgc,gcd->btgd', pooled - u, w_pool.astype(f32)).reshape(B, T, POOL_WIDTH)
    y_b = y_b * pool_scale.astype(f32)
    return jnp.concatenate([y_a, y_b], axis=-1).astype(h.dtype) @ w_out


def _partial_rope(x, cos, sin):
    half = ROPE_DIMS // 2
    x1 = x[..., :half]
    x2 = x[..., half:ROPE_DIMS]
    c = cos[:, None, None, :]
    s = sin[:, None, None, :]
    return jnp.concatenate([x1 * c - x2 * s, x2 * c + x1 * s, x[..., ROPE_DIMS:]], axis=-1)


def _diff_attention(h, w_qkv, lq1, lk1, lq2, lk2, subln_w, w_out, lambda_init, cos, sin):
    B, T, _ = h.shape
    f32 = jnp.float32
    H, dh, dv = ATT_HEADS, ATT_HEAD_DIM, ATT_V_DIM
    qkv = (h @ w_qkv).astype(f32)
    q = qkv[..., :2 * H * dh].reshape(B, T, H, 2, dh)
    k = qkv[..., 2 * H * dh:4 * H * dh].reshape(B, T, H, 2, dh)
    v = qkv[..., 4 * H * dh:].reshape(B, T, H, dv)
    q = _partial_rope(q, cos, sin)
    k = _partial_rope(k, cos, sin)
    lam = (jnp.exp(jnp.sum(lq1.astype(f32) * lk1.astype(f32)))
           - jnp.exp(jnp.sum(lq2.astype(f32) * lk2.astype(f32))) + lambda_init)
    nb = T // Q_BLOCK
    qb = q.reshape(B, nb, Q_BLOCK, H, 2, dh).transpose(1, 0, 3, 4, 2, 5)
    kt = k.transpose(0, 2, 3, 1, 4)
    vt = v.transpose(0, 2, 1, 3)
    key_pos = jnp.arange(T)
    scale = ATT_HEAD_DIM ** -0.5

    def attend(args):
        q_blk, bi = args
        s = jnp.einsum('bhcqd,bhckd->bhcqk', q_blk, kt) * scale
        q_pos = bi * Q_BLOCK + jnp.arange(Q_BLOCK)
        s = jnp.where(key_pos[None, :] <= q_pos[:, None], s, -jnp.inf)
        pr = jax.nn.softmax(s, axis=-1)
        return jnp.einsum('bhqk,bhkd->bhqd', pr[:, :, 0] - lam * pr[:, :, 1], vt)

    o = lax.map(attend, (qb, jnp.arange(nb)))
    o = o.transpose(1, 0, 3, 2, 4).reshape(B, T, H, dv)
    o = o * lax.rsqrt(jnp.mean(o * o, axis=-1, keepdims=True) + SUBLN_EPS)
    o = o * subln_w.astype(f32) * (1.0 - lambda_init)
    return o.reshape(B, T, H * dv).astype(h.dtype) @ w_out


def _expert_dispatch(x, eid, wts, w_gate, w_up, w_down):
    n_tok, D = x.shape
    M = n_tok * MOE_TOP_K
    eid = eid.reshape(M)
    wts = wts.reshape(M)
    tok = jnp.repeat(jnp.arange(n_tok), MOE_TOP_K)
    order = jnp.argsort(eid)
    eid_s, tok_s, wt_s = eid[order], tok[order], wts[order]
    counts = jnp.bincount(eid, length=MOE_EXPERTS)
    padded = (counts + MOE_BLOCK - 1) // MOE_BLOCK * MOE_BLOCK
    pad_end = jnp.cumsum(padded)
    pad_start = pad_end - padded
    start = jnp.cumsum(counts) - counts
    dest = pad_start[eid_s] + jnp.arange(M) - start[eid_s]
    n_blocks = (M + MOE_EXPERTS * (MOE_BLOCK - 1) + MOE_BLOCK - 1) // MOE_BLOCK
    P = n_blocks * MOE_BLOCK
    xp = jnp.zeros((P, D), x.dtype).at[dest].set(x[tok_s])
    blk_e = jnp.minimum(jnp.searchsorted(pad_end, jnp.arange(n_blocks) * MOE_BLOCK, side='right'),
                        MOE_EXPERTS - 1)

    def expert_block(args):
        xb, e = args
        return (jax.nn.silu(xb @ w_gate[e]) * (xb @ w_up[e])) @ w_down[e]

    yp = lax.map(expert_block, (xp.reshape(n_blocks, MOE_BLOCK, D), blk_e)).reshape(P, D)
    y = yp[dest] * wt_s[:, None].astype(x.dtype)
    return jnp.zeros((n_tok, D), x.dtype).at[tok_s].add(y)


def _hier_moe(h, w_group, b_group, w_expert, b_expert, w_gate, w_up, w_down):
    B, T, D = h.shape
    f32 = jnp.float32
    x = h.reshape(B * T, D)
    xf = x.astype(f32)
    p_grp = jax.nn.softmax(xf @ w_group.astype(f32) + b_group.astype(f32), axis=-1)
    g_idx = jnp.argmax(p_grp, axis=-1)
    g_w = jnp.take_along_axis(p_grp, g_idx[:, None], axis=-1)
    e_logits = (xf @ w_expert.astype(f32) + b_expert.astype(f32)).reshape(-1, MOE_GROUPS, MOE_EXPERTS_PER_GROUP)
    e_in = jnp.take_along_axis(e_logits, g_idx[:, None, None], axis=1)[:, 0]
    top_v, top_i = lax.top_k(e_in, MOE_TOP_K)
    wts = jax.nn.softmax(top_v, axis=-1) * g_w
    eid = (g_idx[:, None] * MOE_EXPERTS_PER_GROUP + top_i).astype(jnp.int32)
    return _expert_dispatch(x, eid, wts, w_gate, w_up, w_down).reshape(B, T, D)


def setup_inputs(seed: int = 0) -> dict:
    key = jax.random.key(seed)
    ks = iter(jax.random.split(key, 48))
    f32 = jnp.float32
    nrm = lambda shape, scale: jax.random.normal(next(ks), shape, f32) * scale
    uni = lambda shape, lo, hi: jax.random.uniform(next(ks), shape, f32, lo, hi)
    D = D_MODEL
    return {
        'x': nrm((BATCH, SEQ, D), 1.0),
        'norm_mix': 1.0 + nrm((DEPTH, D), 0.05),
        'norm_ffn': 1.0 + nrm((DEPTH, D), 0.05),
        'final_norm': 1.0 + nrm((D,), 0.05),
        'a_w_in': nrm((N_EVEN, D, IN_WIDTH), D ** -0.5),
        'a_mu': uni((N_EVEN, SHIFT_WIDTH), 0.0, 1.0),
        'a_w0': uni((N_EVEN, RWKV_WIDTH), -6.0, 1.0),
        'a_w2': nrm((N_EVEN, DECAY_LORA, RWKV_WIDTH), 0.5 * DECAY_LORA ** -0.5),
        'a_a0': nrm((N_EVEN, RWKV_WIDTH), 0.1),
        'a_a2': nrm((N_EVEN, ICLR_LORA, RWKV_WIDTH), ICLR_LORA ** -0.5),
        'a_g2': nrm((N_EVEN, GATE_LORA, RWKV_WIDTH), GATE_LORA ** -0.5),
        'a_k_k': 0.85 + nrm((N_EVEN, RWKV_WIDTH), 0.05),
        'a_k_a': 1.0 + nrm((N_EVEN, RWKV_WIDTH), 0.05),
        'a_r_k': nrm((N_EVEN, RWKV_HEADS, RWKV_HEAD_DIM), 0.1),
        'a_ln_w': 1.0 + nrm((N_EVEN, RWKV_WIDTH), 0.05),
        'a_ln_b': nrm((N_EVEN, RWKV_WIDTH), 0.01),
        'b_w_pool': nrm((N_EVEN, POOL_GROUPS, POOL_GROUP_DIM, POOL_GROUP_DIM), POOL_GROUP_DIM ** -0.5),
        'b_pool_scale': 1.0 + nrm((N_EVEN, POOL_WIDTH), 0.05),
        'ab_w_out': nrm((N_EVEN, RWKV_WIDTH + POOL_WIDTH, D), (RWKV_WIDTH + POOL_WIDTH) ** -0.5),
        'c_w_qkv': nrm((N_ODD, D, 4 * ATT_HEADS * ATT_HEAD_DIM + ATT_HEADS * ATT_V_DIM), D ** -0.5),
        'c_lambda_q1': nrm((N_ODD, ATT_HEAD_DIM), 0.1),
        'c_lambda_k1': nrm((N_ODD, ATT_HEAD_DIM), 0.1),
        'c_lambda_q2': nrm((N_ODD, ATT_HEAD_DIM), 0.1),
        'c_lambda_k2': nrm((N_ODD, ATT_HEAD_DIM), 0.1),
        'c_subln': 1.0 + nrm((N_ODD, ATT_V_DIM), 0.05),
        'c_w_out': nrm((N_ODD, ATT_HEADS * ATT_V_DIM, D), (ATT_HEADS * ATT_V_DIM) ** -0.5),
        'moe_w_group': nrm((DEPTH, D, MOE_GROUPS), D ** -0.5),
        'moe_b_group': nrm((DEPTH, MOE_GROUPS), 0.01),
        'moe_w_expert': nrm((DEPTH, D, MOE_EXPERTS), D ** -0.5),
        'moe_b_expert': nrm((DEPTH, MOE_EXPERTS), 0.01),
        'moe_w_gate': nrm((DEPTH, MOE_EXPERTS, D, MOE_HIDDEN), D ** -0.5),
        'moe_w_up': nrm((DEPTH, MOE_EXPERTS, D, MOE_HIDDEN), D ** -0.5),
        'moe_w_down': nrm((DEPTH, MOE_EXPERTS, MOE_HIDDEN, D), MOE_HIDDEN ** -0.5),
    }


def reference(x, norm_mix, norm_ffn, final_norm, a_w_in, a_mu, a_w0, a_w2, a_a0, a_a2, a_g2,
              a_k_k, a_k_a, a_r_k, a_ln_w, a_ln_b, b_w_pool, b_pool_scale, ab_w_out,
              c_w_qkv, c_lambda_q1, c_lambda_k1, c_lambda_q2, c_lambda_k2, c_subln, c_w_out,
              moe_w_group, moe_b_group, moe_w_expert, moe_b_expert, moe_w_gate, moe_w_up, moe_w_down):
    T = x.shape[1]
    pos = jnp.arange(T, dtype=jnp.float32)
    inv_freq = jnp.power(ROPE_THETA, -jnp.arange(0, ROPE_DIMS, 2, dtype=jnp.float32) / ROPE_DIMS)
    ang = pos[:, None] * inv_freq[None, :]
    cos, sin = jnp.cos(ang), jnp.sin(ang)
    for layer in range(DEPTH):
        i = layer // 2
        hn = _rmsnorm(x, norm_mix[layer], RMS_EPS)
        if layer % 2 == 0:
            x = x + _rwkv_pool_mixer(hn, a_w_in[i], a_mu[i], a_w0[i], a_w2[i], a_a0[i], a_a2[i], a_g2[i],
                                     a_k_k[i], a_k_a[i], a_r_k[i], a_ln_w[i], a_ln_b[i],
                                     b_w_pool[i], b_pool_scale[i], ab_w_out[i])
        else:
            lambda_init = 0.8 - 0.6 * math.exp(-0.3 * layer)
            x = x + _diff_attention(hn, c_w_qkv[i], c_lambda_q1[i], c_lambda_k1[i], c_lambda_q2[i],
                                    c_lambda_k2[i], c_subln[i], c_w_out[i], lambda_init, cos, sin)
        hn = _rmsnorm(x, norm_ffn[layer], RMS_EPS)
        x = x + _hier_moe(hn, moe_w_group[layer], moe_b_group[layer], moe_w_expert[layer],
                          moe_b_expert[layer], moe_w_gate[layer], moe_w_up[layer], moe_w_down[layer])
    return _rmsnorm(x, final_norm, RMS_EPS)
```

```cpp
#include <hip/hip_runtime.h>
#include <stdint.h>
#include <math.h>

namespace {
constexpr int D = 1024, SEQ = 4096, NTOK = 16384;
constexpr int RW = 512;
constexpr int SHIFTW = 1792, INW = 2304, QKVW = 3072;
constexpr int NEXP = 32, MH = 512, MBLK = 128;
constexpr int NASSIGN = NTOK * 2;
constexpr int PMAX = 36864;
constexpr int NBLK_MAX = PMAX / MBLK;

__device__ __forceinline__ float wave_sum(float v) {
#pragma unroll
    for (int o = 32; o > 0; o >>= 1) v += __shfl_xor(v, o);
    return v;
}
__device__ __forceinline__ float wave_max(float v) {
#pragma unroll
    for (int o = 32; o > 0; o >>= 1) v = fmaxf(v, __shfl_xor(v, o));
    return v;
}
__device__ __forceinline__ float block_sum(float v, float* red) {
    v = wave_sum(v);
    const int w = threadIdx.x >> 6, nw = blockDim.x >> 6;
    __syncthreads();
    if ((threadIdx.x & 63) == 0) red[w] = v;
    __syncthreads();
    float s = 0.f;
    for (int i = 0; i < nw; ++i) s += red[i];
    return s;
}
__device__ __forceinline__ float block_max(float v, float* red) {
    v = wave_max(v);
    const int w = threadIdx.x >> 6, nw = blockDim.x >> 6;
    __syncthreads();
    if ((threadIdx.x & 63) == 0) red[w] = v;
    __syncthreads();
    float s = -INFINITY;
    for (int i = 0; i < nw; ++i) s = fmaxf(s, red[i]);
    return s;
}
__device__ __forceinline__ float sigmoidf_(float x) { return 1.f / (1.f + expf(-x)); }

__global__ void __launch_bounds__(256) k_rmsnorm(const float* x, const float* g, float* out) {
    __shared__ float red[16];
    const size_t row = blockIdx.x;
    const float4 v = ((const float4*)(x + row * D))[threadIdx.x];
    float ss = v.x * v.x + v.y * v.y + v.z * v.z + v.w * v.w;
    ss = block_sum(ss, red);
    const float rs = rsqrtf(ss * (1.f / D) + 1e-6f);
    const float4 gg = ((const float4*)g)[threadIdx.x];
    float4 o; o.x = v.x * rs * gg.x; o.y = v.y * rs * gg.y; o.z = v.z * rs * gg.z; o.w = v.w * rs * gg.w;
    ((float4*)(out + row * D))[threadIdx.x] = o;
}

struct GemmArgs {
    const float* A; int lda; const float* B; int ldb; float* C; int ldc; int M, N, K;
    const float* R; int ldr;
    const int* arow;
    const int* blk_e;
    size_t b_stride;
    const int* nblk;
};
__global__ void __launch_bounds__(256) k_gemm_naive(GemmArgs a) {
    __shared__ float As[16][65];
    __shared__ float Bs[16][65];
    const int tx = threadIdx.x & 15, ty = threadIdx.x >> 4;
    const int m0 = blockIdx.y * 64, n0 = blockIdx.x * 64;
    if (a.nblk && (m0 / MBLK) >= *a.nblk) return;
    const float* B = a.B;
    if (a.blk_e) B += (size_t)a.blk_e[m0 / MBLK] * a.b_stride;
    float acc[4][4];
#pragma unroll
    for (int i = 0; i < 4; ++i)
#pragma unroll
        for (int j = 0; j < 4; ++j) acc[i][j] = 0.f;
    for (int k0 = 0; k0 < a.K; k0 += 16) {
#pragma unroll
        for (int i = 0; i < 4; ++i) {
            const int idx = threadIdx.x + i * 256;
            const int r = idx >> 4, kk = idx & 15;
            const int grow = m0 + r;
            const int srow = a.arow ? a.arow[grow] : grow;
            As[kk][r] = (srow >= 0) ? a.A[(size_t)srow * a.lda + k0 + kk] : 0.f;
            const int kb = idx >> 6, c = idx & 63;
            Bs[kb][c] = B[(size_t)(k0 + kb) * a.ldb + n0 + c];
        }
        __syncthreads();
#pragma unroll
        for (int kk = 0; kk < 16; ++kk) {
            float ar[4], br[4];
#pragma unroll
            for (int i = 0; i < 4; ++i) ar[i] = As[kk][ty * 4 + i];
#pragma unroll
            for (int j = 0; j < 4; ++j) br[j] = Bs[kk][tx * 4 + j];
#pragma unroll
            for (int i = 0; i < 4; ++i)
#pragma unroll
                for (int j = 0; j < 4; ++j) acc[i][j] += ar[i] * br[j];
        }
        __syncthreads();
    }
#pragma unroll
    for (int i = 0; i < 4; ++i) {
        const size_t row = m0 + ty * 4 + i;
#pragma unroll
        for (int j = 0; j < 4; ++j) {
            const int col = n0 + tx * 4 + j;
            float v = acc[i][j];
            if (a.R) v += a.R[row * a.ldr + col];
            a.C[row * a.ldc + col] = v;
        }
    }
}

__global__ void __launch_bounds__(512) k_rwkv_prep(const float* p, const float* mu, const float* w0, const float* w2,
                                                   const float* a0, const float* a2, const float* k_k, const float* k_a,
                                                   float* r_o, float* w_o, float* k_o, float* v_o, float* kk_o, float* b_o) {
    __shared__ float z[SHIFTW];
    __shared__ float tw[64];
    const int tok = blockIdx.x, t = tok % SEQ, tid = threadIdx.x;
    const float* pc = p + (size_t)tok * INW;
    for (int c = tid; c < SHIFTW; c += 512) {
        const float cur = pc[c];
        const float prev = t > 0 ? pc[c - INW] : 0.f;
        z[c] = cur + (prev - cur) * mu[c];
    }
    __syncthreads();
    if (tid < 64) tw[tid] = tanhf(z[1536 + tid]);
    __syncthreads();
    const int c = tid;
    float accw = w0[c], acca = a0[c];
    for (int m = 0; m < 64; ++m) { accw += tw[m] * w2[m * RW + c]; acca += z[1600 + m] * a2[m * RW + c]; }
    const float xs = -accw;
    const float sp = xs > 20.f ? xs : log1pf(expf(xs));
    const float wlog = -sp - 0.5f;
    const float decay = expf(-expf(wlog));
    const float a = sigmoidf_(acca);
    const float r = z[c], k = z[512 + c], v = z[1024 + c];
    float kk = k * k_k[c];
    const float ss = wave_sum(kk * kk);
    kk = kk / fmaxf(sqrtf(ss), 1e-12f);
    const float k2 = k * (1.f + (a - 1.f) * k_a[c]);
    const size_t o = (size_t)tok * RW + c;
    r_o[o] = r; w_o[o] = decay; k_o[o] = k2; v_o[o] = v; kk_o[o] = kk; b_o[o] = kk * a;
}

__global__ void __launch_bounds__(64) k_scan_naive(const float* r, const float* w, const float* k, const float* v,
                                                   const float* kk, const float* b, float* y) {
    const int bh = blockIdx.x, bb = bh >> 3, h = bh & 7, i = threadIdx.x;
    __shared__ float sr[64], sw[64], sk[64], skk[64], sb[64];
    float S[64];
#pragma unroll
    for (int j = 0; j < 64; ++j) S[j] = 0.f;
    size_t off = ((size_t)bb * SEQ) * RW + h * 64 + i;
    float nr = r[off], nw = w[off], nk = k[off], nv = v[off], nkk = kk[off], nb = b[off];
    for (int t = 0; t < SEQ; ++t) {
        __syncthreads();
        sr[i] = nr; sw[i] = nw; sk[i] = nk; skk[i] = nkk; sb[i] = nb;
        const float vi = nv;
        __syncthreads();
        if (t + 1 < SEQ) {
            const size_t o2 = off + RW;
            nr = r[o2]; nw = w[o2]; nk = k[o2]; nv = v[o2]; nkk = kk[o2]; nb = b[o2];
        }
        float sa = 0.f;
#pragma unroll
        for (int j = 0; j < 64; ++j) sa += S[j] * skk[j];
        float yy = 0.f;
#pragma unroll
        for (int j = 0; j < 64; ++j) {
            S[j] = S[j] * sw[j] - sa * sb[j] + vi * sk[j];
            yy += S[j] * sr[j];
        }
        y[off] = yy;
        off += RW;
    }
}

__global__ void __launch_bounds__(512) k_rwkv_post(const float* p, const float* mu, const float* g2, const float* ln_w, const float* ln_b,
                                                   const float* r_k, const float* y, const float* r_i, const float* k_i, const float* v_i,
                                                   float* ycat) {
    __shared__ float sg[128];
    const int tok = blockIdx.x, t = tok % SEQ, tid = threadIdx.x;
    const float* pc = p + (size_t)tok * INW;
    if (tid < 128) {
        const int c = 1664 + tid;
        const float cur = pc[c];
        const float prev = t > 0 ? pc[c - INW] : 0.f;
        sg[tid] = sigmoidf_(cur + (prev - cur) * mu[c]);
    }
    __syncthreads();
    const int c = tid;
    float g = 0.f;
    for (int m = 0; m < 128; ++m) g += sg[m] * g2[m * RW + c];
    const size_t o = (size_t)tok * RW + c;
    const float yv = y[o];
    const float mean = wave_sum(yv) * (1.f / 64.f);
    const float d = yv - mean;
    const float var = wave_sum(d * d) * (1.f / 64.f);
    float yn = d * rsqrtf(var + 64e-5f);
    yn = yn * ln_w[c] + ln_b[c];
    const float bonus = wave_sum(r_i[o] * k_i[o] * r_k[c]);
    yn += bonus * v_i[o];
    ycat[(size_t)tok * D + c] = yn * g;
}

__global__ void __launch_bounds__(512) k_pool(const float* p, const float* w_pool, const float* pool_scale, float* ycat) {
    __shared__ float sd[512];
    const int tok = blockIdx.x, t = tok % SEQ, c = threadIdx.x;
    const int gi = c >> 7, win = 2 << gi;
    const float* pu = p + (size_t)tok * INW + SHIFTW + c;
    const int cnt = (t + 1 < win) ? (t + 1) : win;
    float s = 0.f;
    for (int q = 0; q < cnt; ++q) s += pu[-(ptrdiff_t)q * INW];
    sd[c] = s / (float)cnt - pu[0];
    __syncthreads();
    const int dc = c & 127;
    const float* wp = w_pool + (size_t)gi * 128 * 128 + dc;
    float acc = 0.f;
    for (int cc = 0; cc < 128; ++cc) acc += sd[gi * 128 + cc] * wp[cc * 128];
    ycat[(size_t)tok * D + RW + c] = acc * pool_scale[c];
}

__global__ void __launch_bounds__(256) k_router(const float* x, const float* gnorm, const float* w_group, const float* b_group,
                                                const float* w_expert, const float* b_expert, float* hn, int* eid, float* wts, int* counts) {
    __shared__ float red[16];
    __shared__ float part[4][36];
    __shared__ float logit[36];
    const int tok = blockIdx.x, tid = threadIdx.x;
    const float4 v = ((const float4*)(x + (size_t)tok * D))[tid];
    float ss = v.x * v.x + v.y * v.y + v.z * v.z + v.w * v.w;
    ss = block_sum(ss, red);
    const float rs = rsqrtf(ss * (1.f / D) + 1e-6f);
    const float4 gg = ((const float4*)gnorm)[tid];
    float h[4] = {v.x * rs * gg.x, v.y * rs * gg.y, v.z * rs * gg.z, v.w * rs * gg.w};
    ((float4*)(hn + (size_t)tok * D))[tid] = make_float4(h[0], h[1], h[2], h[3]);
    const int k0 = tid * 4;
    for (int j = 0; j < 36; ++j) {
        float s = 0.f;
#pragma unroll
        for (int q = 0; q < 4; ++q) {
            const float wv = (j < 4) ? w_group[(size_t)(k0 + q) * 4 + j] : w_expert[(size_t)(k0 + q) * 32 + (j - 4)];
            s += h[q] * wv;
        }
        s = wave_sum(s);
        if ((tid & 63) == 0) part[tid >> 6][j] = s;
    }
    __syncthreads();
    if (tid < 36) {
        float s = part[0][tid] + part[1][tid] + part[2][tid] + part[3][tid];
        s += (tid < 4) ? b_group[tid] : b_expert[tid - 4];
        logit[tid] = s;
    }
    __syncthreads();
    if (tid == 0) {
        int gi = 0; float gm = logit[0];
        for (int j = 1; j < 4; ++j) if (logit[j] > gm) { gm = logit[j]; gi = j; }
        float den = 0.f;
        for (int j = 0; j < 4; ++j) den += expf(logit[j] - gm);
        const float gw = 1.f / den;
        const float* el = logit + 4 + gi * 8;
        int i0 = 0; float v0 = el[0];
        for (int j = 1; j < 8; ++j) if (el[j] > v0) { v0 = el[j]; i0 = j; }
        int i1 = -1; float v1 = -INFINITY;
        for (int j = 0; j < 8; ++j) if (j != i0 && el[j] > v1) { v1 = el[j]; i1 = j; }
        const float e1 = expf(v1 - v0);
        const float p0 = 1.f / (1.f + e1), p1 = e1 / (1.f + e1);
        const int ea = gi * 8 + i0, eb = gi * 8 + i1;
        eid[tok * 2] = ea; eid[tok * 2 + 1] = eb;
        wts[tok * 2] = p0 * gw; wts[tok * 2 + 1] = p1 * gw;
        atomicAdd(&counts[ea], 1); atomicAdd(&counts[eb], 1);
    }
}

__global__ void k_moe_plan(int* ctl) {
    if (threadIdx.x == 0) {
        int start = 0;
        for (int e = 0; e < NEXP; ++e) {
            const int c = ctl[e];
            const int padded = (c + MBLK - 1) / MBLK * MBLK;
            ctl[64 + e] = start;
            ctl[32 + e] = 0;
            for (int q = 0; q < padded / MBLK; ++q) ctl[128 + start / MBLK + q] = e;
            start += padded;
        }
        ctl[96] = start / MBLK;
    }
}
__global__ void __launch_bounds__(256) k_moe_assign(const int* eid, const float* wts, int* ctl, int* slot_tok, int* tok_slot) {
    const int a = blockIdx.x * 256 + threadIdx.x;
    if (a >= NASSIGN) return;
    const int e = eid[a];
    const int pos = atomicAdd(&ctl[32 + e], 1);
    const int slot = ctl[64 + e] + pos;
    slot_tok[slot] = a >> 1;
    tok_slot[a] = slot;
}
__global__ void __launch_bounds__(256) k_act(float* hg, const float* hu, const int* nblk) {
    const size_t n = (size_t)(*nblk) * MBLK * MH;
    for (size_t i = (size_t)blockIdx.x * 256 + threadIdx.x; i < n; i += (size_t)gridDim.x * 256) {
        const float g = hg[i];
        hg[i] = g / (1.f + expf(-g)) * hu[i];
    }
}
__global__ void __launch_bounds__(256) k_combine(float* x, const float* Y, const int* tok_slot, const float* wts) {
    const int tok = blockIdx.x, tid = threadIdx.x;
    const int s0 = tok_slot[tok * 2], s1 = tok_slot[tok * 2 + 1];
    const float w0 = wts[tok * 2], w1 = wts[tok * 2 + 1];
    float4 v = ((float4*)(x + (size_t)tok * D))[tid];
    const float4 a = ((const float4*)(Y + (size_t)s0 * D))[tid];
    const float4 b = ((const float4*)(Y + (size_t)s1 * D))[tid];
    v.x += w0 * a.x + w1 * b.x; v.y += w0 * a.y + w1 * b.y; v.z += w0 * a.z + w1 * b.z; v.w += w0 * a.w + w1 * b.w;
    ((float4*)(x + (size_t)tok * D))[tid] = v;
}

__global__ void __launch_bounds__(256) k_rope_table(float* cs) {
    const int i = blockIdx.x * 256 + threadIdx.x;
    if (i >= SEQ * 8) return;
    const int t = i >> 3, f = i & 7;
    const double inv = exp(-log(500000.0) * (double)f / 8.0);
    const double ang = (double)t * inv;
    cs[i * 2] = (float)cos(ang); cs[i * 2 + 1] = (float)sin(ang);
}
__global__ void __launch_bounds__(256) k_rope(float* qkv, const float* cs) {
    const int tok = blockIdx.x, t = tok % SEQ, tid = threadIdx.x;
    const int i = tid & 7, comp = (tid >> 3) & 1, h = (tid >> 4) & 7, qk = tid >> 7;
    float* base = qkv + (size_t)tok * QKVW + qk * 1024 + h * 128 + comp * 64;
    const float c = cs[(t * 8 + i) * 2], s = cs[(t * 8 + i) * 2 + 1];
    const float x1 = base[i], x2 = base[8 + i];
    base[i] = x1 * c - x2 * s;
    base[8 + i] = x2 * c + x1 * s;
}

__global__ void __launch_bounds__(256) k_attn_naive(const float* qkv, const float* lq1, const float* lk1, const float* lq2, const float* lk2,
                                                    const float* subln, float lambda_init, float* o) {
    __shared__ float s1[SEQ], s2[SEQ];
    __shared__ float q[128];
    __shared__ float red[16];
    __shared__ float oacc[2][128];
    const int tok = blockIdx.x, h = blockIdx.y, t = tok % SEQ, tid = threadIdx.x;
    const size_t tok0 = (size_t)(tok - t);
    if (tid < 128) q[tid] = qkv[(size_t)tok * QKVW + h * 128 + tid];
    float la = 0.f, lb = 0.f;
    if (tid < 64) { la = lq1[tid] * lk1[tid]; lb = lq2[tid] * lk2[tid]; }
    la = block_sum(la, red); lb = block_sum(lb, red);
    const float lam = expf(la) - expf(lb) + lambda_init;
    __syncthreads();
    float m1 = -INFINITY, m2 = -INFINITY;
    {
        const int sub = tid & 15, grp = tid >> 4;
        const float4 qa = ((const float4*)q)[sub], qb = ((const float4*)q)[16 + sub];
        for (int j = grp; j <= t; j += 16) {
            const float4* kr = (const float4*)(qkv + (tok0 + j) * QKVW + 1024 + h * 128);
            const float4 ka = kr[sub], kb = kr[16 + sub];
            float a = qa.x * ka.x + qa.y * ka.y + qa.z * ka.z + qa.w * ka.w;
            float b = qb.x * kb.x + qb.y * kb.y + qb.z * kb.z + qb.w * kb.w;
#pragma unroll
            for (int o = 8; o > 0; o >>= 1) { a += __shfl_xor(a, o); b += __shfl_xor(b, o); }
            a *= 0.125f; b *= 0.125f;
            if (sub == 0) { s1[j] = a; s2[j] = b; }
            m1 = fmaxf(m1, a); m2 = fmaxf(m2, b);
        }
    }
    m1 = block_max(m1, red); m2 = block_max(m2, red);
    float l1 = 0.f, l2 = 0.f;
    for (int j = tid; j <= t; j += 256) {
        const float e1 = expf(s1[j] - m1), e2 = expf(s2[j] - m2);
        s1[j] = e1; s2[j] = e2; l1 += e1; l2 += e2;
    }
    l1 = block_sum(l1, red); l2 = block_sum(l2, red);
    const float i1 = 1.f / l1, i2 = lam / l2;
    __syncthreads();
    const int d = tid & 127, half = tid >> 7;
    float acc = 0.f;
    for (int j = half; j <= t; j += 2) {
        const float pj = s1[j] * i1 - s2[j] * i2;
        acc += pj * qkv[(tok0 + j) * QKVW + 2048 + h * 128 + d];
    }
    oacc[half][d] = acc;
    __syncthreads();
    float ov = 0.f;
    if (tid < 128) ov = oacc[0][tid] + oacc[1][tid];
    const float ssq = block_sum(ov * ov, red);
    if (tid < 128) {
        const float rs = rsqrtf(ssq * (1.f / 128.f) + 1e-5f);
        o[(size_t)tok * D + h * 128 + tid] = ov * rs * subln[tid] * (1.f - lambda_init);
    }
}

}

extern "C" void kernel_launch(void* const* d_in, const int* in_sizes, int n_in, void* d_out, int out_size, void* d_ws, size_t ws_size,
                              hipStream_t stream) {
    const float* x = (const float*)d_in[0];
    const float* norm_mix = (const float*)d_in[1];
    const float* norm_ffn = (const float*)d_in[2];
    const float* final_norm = (const float*)d_in[3];
    const float* a_w_in = (const float*)d_in[4];
    const float* a_mu = (const float*)d_in[5];
    const float* a_w0 = (const float*)d_in[6];
    const float* a_w2 = (const float*)d_in[7];
    const float* a_a0 = (const float*)d_in[8];
    const float* a_a2 = (const float*)d_in[9];
    const float* a_g2 = (const float*)d_in[10];
    const float* a_k_k = (const float*)d_in[11];
    const float* a_k_a = (const float*)d_in[12];
    const float* a_r_k = (const float*)d_in[13];
    const float* a_ln_w = (const float*)d_in[14];
    const float* a_ln_b = (const float*)d_in[15];
    const float* b_w_pool = (const float*)d_in[16];
    const float* b_pool_scale = (const float*)d_in[17];
    const float* ab_w_out = (const float*)d_in[18];
    const float* c_w_qkv = (const float*)d_in[19];
    const float* c_lq1 = (const float*)d_in[20];
    const float* c_lk1 = (const float*)d_in[21];
    const float* c_lq2 = (const float*)d_in[22];
    const float* c_lk2 = (const float*)d_in[23];
    const float* c_subln = (const float*)d_in[24];
    const float* c_w_out = (const float*)d_in[25];
    const float* moe_w_group = (const float*)d_in[26];
    const float* moe_b_group = (const float*)d_in[27];
    const float* moe_w_expert = (const float*)d_in[28];
    const float* moe_b_expert = (const float*)d_in[29];
    const float* moe_w_gate = (const float*)d_in[30];
    const float* moe_w_up = (const float*)d_in[31];
    const float* moe_w_down = (const float*)d_in[32];
    float* xres = (float*)d_out;

    char* ws = (char*)d_ws;
    const size_t MiB = 1024 * 1024;
    float* R0 = (float*)(ws);
    float* R1 = (float*)(ws + 64 * MiB);
    float* R2 = (float*)(ws + 256 * MiB);
    float* R3 = (float*)(ws + 448 * MiB);
    char* SM = ws + 480 * MiB;
    int* ctl = (int*)SM;
    int* eid = (int*)(SM + 8192);
    float* wts = (float*)(SM + 8192 + 131072);
    int* tok_slot = (int*)(SM + 8192 + 2 * 131072);
    int* slot_tok = (int*)(SM + 8192 + 3 * 131072);
    float* cs = (float*)(SM + 8192 + 3 * 131072 + 262144);

    hipMemsetAsync(ctl, 0, 8192, stream);

    const size_t NR = (size_t)NTOK * RW;
    float* r_a = R2; float* w_a = R2 + NR; float* k_a2 = R2 + 2 * NR; float* v_a = R2 + 3 * NR; float* kk_a = R2 + 4 * NR; float* b_a = R2 + 5 * NR;

    k_rmsnorm<<<NTOK, 256, 0, stream>>>(x, norm_mix, R0);
    {
        GemmArgs g{}; g.A = R0; g.lda = D; g.B = a_w_in; g.ldb = INW; g.C = R1; g.ldc = INW; g.M = NTOK; g.N = INW; g.K = D;
        k_gemm_naive<<<dim3(INW / 64, NTOK / 64), 256, 0, stream>>>(g);
    }
    k_rwkv_prep<<<NTOK, 512, 0, stream>>>(R1, a_mu, a_w0, a_w2, a_a0, a_a2, a_k_k, a_k_a, r_a, w_a, k_a2, v_a, kk_a, b_a);
    k_scan_naive<<<32, 64, 0, stream>>>(r_a, w_a, k_a2, v_a, kk_a, b_a, R3);
    k_rwkv_post<<<NTOK, 512, 0, stream>>>(R1, a_mu, a_g2, a_ln_w, a_ln_b, a_r_k, R3, r_a, k_a2, v_a, R0);
    k_pool<<<NTOK, 512, 0, stream>>>(R1, b_w_pool, b_pool_scale, R0);
    {
        GemmArgs g{}; g.A = R0; g.lda = D; g.B = ab_w_out; g.ldb = D; g.C = xres; g.ldc = D; g.M = NTOK; g.N = D; g.K = D; g.R = x; g.ldr = D;
        k_gemm_naive<<<dim3(D / 64, NTOK / 64), 256, 0, stream>>>(g);
    }
    for (int layer = 0; layer < 2; ++layer) {
        if (layer == 1) {
            const float lambda_init = (float)(0.8 - 0.6 * exp(-0.3 * 1.0));
            k_rope_table<<<SEQ * 8 / 256, 256, 0, stream>>>(cs);
            k_rmsnorm<<<NTOK, 256, 0, stream>>>(xres, norm_mix + D, R0);
            {
                GemmArgs g{}; g.A = R0; g.lda = D; g.B = c_w_qkv; g.ldb = QKVW; g.C = R1; g.ldc = QKVW; g.M = NTOK; g.N = QKVW; g.K = D;
                k_gemm_naive<<<dim3(QKVW / 64, NTOK / 64), 256, 0, stream>>>(g);
            }
            k_rope<<<NTOK, 256, 0, stream>>>(R1, cs);
            k_attn_naive<<<dim3(NTOK, 8), 256, 0, stream>>>(R1, c_lq1, c_lk1, c_lq2, c_lk2, c_subln, lambda_init, R2);
            {
                GemmArgs g{}; g.A = R2; g.lda = D; g.B = c_w_out; g.ldb = D; g.C = xres; g.ldc = D; g.M = NTOK; g.N = D; g.K = D; g.R = xres; g.ldr = D;
                k_gemm_naive<<<dim3(D / 64, NTOK / 64), 256, 0, stream>>>(g);
            }
        }
        int* lctl = ctl + layer * 1024;
        k_router<<<NTOK, 256, 0, stream>>>(xres, norm_ffn + layer * D, moe_w_group + (size_t)layer * D * 4, moe_b_group + layer * 4,
                                           moe_w_expert + (size_t)layer * D * 32, moe_b_expert + layer * 32, R0, eid, wts, lctl);
        k_moe_plan<<<1, 64, 0, stream>>>(lctl);
        hipMemsetAsync(slot_tok, 0xFF, PMAX * 4, stream);
        k_moe_assign<<<NASSIGN / 256, 256, 0, stream>>>(eid, wts, lctl, slot_tok, tok_slot);
        float* Hg = R2; float* Hu = R2 + (size_t)PMAX * MH; float* Y = R1;
        const size_t wl = (size_t)layer * NEXP * D * MH;
        {
            GemmArgs g{}; g.A = R0; g.lda = D; g.B = moe_w_gate + wl; g.ldb = MH; g.C = Hg; g.ldc = MH; g.M = PMAX; g.N = MH; g.K = D;
            g.arow = slot_tok; g.blk_e = lctl + 128; g.b_stride = (size_t)D * MH; g.nblk = lctl + 96;
            k_gemm_naive<<<dim3(MH / 64, PMAX / 64), 256, 0, stream>>>(g);
            g.B = moe_w_up + wl; g.C = Hu;
            k_gemm_naive<<<dim3(MH / 64, PMAX / 64), 256, 0, stream>>>(g);
        }
        k_act<<<2048, 256, 0, stream>>>(Hg, Hu, lctl + 96);
        {
            GemmArgs g{}; g.A = Hg; g.lda = MH; g.B = moe_w_down + wl; g.ldb = D; g.C = Y; g.ldc = D; g.M = PMAX; g.N = D; g.K = MH;
            g.blk_e = lctl + 128; g.b_stride = (size_t)MH * D; g.nblk = lctl + 96;
            k_gemm_naive<<<dim3(D / 64, PMAX / 64), 256, 0, stream>>>(g);
        }
        k_combine<<<NTOK, 256, 0, stream>>>(xres, Y, tok_slot, wts);
    }
    k_rmsnorm<<<NTOK, 256, 0, stream>>>(xres, final_norm, xres);
}
```

```cpp
#define MK_PER_PHASE 0
#include <hip/hip_runtime.h>
#include <stdint.h>
#include <math.h>

#define LAS __attribute__((address_space(3)))
typedef unsigned short bf16_t;
typedef unsigned u32x4_t __attribute__((ext_vector_type(4)));
typedef unsigned u32x2_t __attribute__((ext_vector_type(2)));

namespace {
constexpr int D = 1024, SEQ = 4096, NTOK = 16384;
constexpr int RW = 512;
constexpr int SHIFTW = 1792, INW = 2304, QKVW = 3072;
constexpr int NEXP = 32, MH = 512, MBLK = 256;
constexpr int NASSIGN = NTOK * 2;
constexpr int NBLK_MAX = 159;
constexpr int PMAX = NBLK_MAX * MBLK;

__device__ __forceinline__ unsigned f2bf(float f) { unsigned u = __builtin_bit_cast(unsigned, f); return (u + 0x7fffu + ((u >> 16) & 1u)) >> 16; }
__device__ __forceinline__ unsigned pk2(float lo, float hi) { return f2bf(lo) | (f2bf(hi) << 16); }
__device__ __forceinline__ float bf2f(bf16_t b) { return __builtin_bit_cast(float, (unsigned)b << 16); }
__device__ __forceinline__ float bflo(unsigned w) { return __builtin_bit_cast(float, w << 16); }
__device__ __forceinline__ float bfhi(unsigned w) { return __builtin_bit_cast(float, w & 0xffff0000u); }

__device__ __forceinline__ float wave_sum(float v) {
#pragma unroll
    for (int o = 32; o > 0; o >>= 1) v += __shfl_xor(v, o);
    return v;
}
__device__ __forceinline__ float wave_max(float v) {
#pragma unroll
    for (int o = 32; o > 0; o >>= 1) v = fmaxf(v, __shfl_xor(v, o));
    return v;
}
__device__ __forceinline__ float block_sum(float v, float* red) {
    v = wave_sum(v);
    const int w = threadIdx.x >> 6, nw = blockDim.x >> 6;
    __syncthreads();
    if ((threadIdx.x & 63) == 0) red[w] = v;
    __syncthreads();
    float s = 0.f;
    for (int i = 0; i < nw; ++i) s += red[i];
    return s;
}
__device__ __forceinline__ float block_max(float v, float* red) {
    v = wave_max(v);
    const int w = threadIdx.x >> 6, nw = blockDim.x >> 6;
    __syncthreads();
    if ((threadIdx.x & 63) == 0) red[w] = v;
    __syncthreads();
    float s = -INFINITY;
    for (int i = 0; i < nw; ++i) s = fmaxf(s, red[i]);
    return s;
}
__device__ __forceinline__ float sigmoidf_(float x) { return 1.f / (1.f + expf(-x)); }
}
namespace pg8 {
#define PG8_LAS __attribute__((address_space(3)))
typedef unsigned short bf16_t;
typedef short bf16x8 __attribute__((ext_vector_type(8)));
typedef float f32x4 __attribute__((ext_vector_type(4)));
typedef unsigned u32x4 __attribute__((ext_vector_type(4)));
constexpr int BM = 256, BK = 64, HALF = 128, HTB = HALF * BK * 2  , STAGE_BYTES = 8 * HTB, NXCD = 8, WGM = 8;

__host__ __device__ __forceinline__ int lds_byte(int r, int c) { const int st = (r >> 4) * 2 + (c >> 5), rr = r & 15, cc = c & 31, ob = rr * 64 + cc * 2; return st * 1024 + (ob ^ (((ob >> 9) & 1) << 5)); }
__host__ __device__ __forceinline__ void stage_rc(int b, int& R, int& C) { const int st = b / 1024, sb = b % 1024, swz = sb ^ (((sb >> 9) & 1) << 5); R = (st >> 1) * 16 + swz / 64; C = (st & 1) * 32 + (swz % 64) / 2; }
__host__ __device__ __forceinline__ int perm32(int rho) { const int n = rho >> 4, i = rho & 15; return 8 * (i >> 2) + 4 * n + (i & 3); }

struct Unit { int pm, pn; size_t boff; };
struct Gemm { const bf16_t* A; const bf16_t* Bt; int M, N, K, pad; };

struct StaticOrder {
    int nM, nN, nwg, G, c, pad;
    __host__ __device__ void init(int M, int N, int G_, int c_) { nM = M / BM; nN = N / BM; nwg = nM * nN; G = G_; c = c_; }
    __host__ __device__ bool next(int i, Unit& u) const {
        const long L = (long)i * G + c; if (L >= nwg) return false;
        int wgid = (int)L; { const int q = nwg / NXCD, r = nwg % NXCD, xcd = wgid % NXCD, off = wgid / NXCD; wgid = (xcd < r ? xcd * (q + 1) : r * (q + 1) + (xcd - r) * q) + off; }
        const int nig = WGM * nN, gid = wgid / nig, fm = gid * WGM, gsz = (nM - fm) < WGM ? (nM - fm) : WGM;
        u.pm = fm + ((wgid % nig) % gsz); u.pn = (wgid % nig) / gsz; u.boff = 0; return true;
    }
    __device__ __forceinline__ void a_ready(const Unit&) const {}
    __device__ __forceinline__ void done(const Unit&) const {}
};
__device__ __forceinline__ unsigned cvt_pk_bf16(float lo, float hi) { unsigned r; asm volatile("v_cvt_pk_bf16_f32 %0, %1, %2" : "=v"(r) : "v"(lo), "v"(hi)); return r; }

struct EpiBf16Plain {
    static constexpr bool PERM = true, AFTER_DRAIN = false;
    bf16_t* O; int ldc, pad;
    __device__ __forceinline__ void operator()(const f32x4 (&acc)[2][2][4][2], const Unit& u, int wr, int wc, int fr, int fq) const {
        const int row0 = u.pm * BM + wr * 64 + fr, col0 = u.pn * BM + wc * 32 + 8 * fq;
#pragma unroll
        for (int ai = 0; ai < 2; ++ai)
#pragma unroll
            for (int m = 0; m < 4; ++m) { bf16_t* rowp = O + (size_t)(row0 + ai * HALF + m * 16) * ldc + col0;
#pragma unroll
                for (int bj = 0; bj < 2; ++bj) { const f32x4 v0 = acc[ai][bj][m][0], v1 = acc[ai][bj][m][1];
                    u32x4 w; w.x = cvt_pk_bf16(v0[0], v0[1]); w.y = cvt_pk_bf16(v0[2], v0[3]); w.z = cvt_pk_bf16(v1[0], v1[1]); w.w = cvt_pk_bf16(v1[2], v1[3]);
                    *(u32x4*)(rowp + bj * HALF) = w; } }
    }
};
struct EpiResF32 {
    static constexpr bool PERM = false, AFTER_DRAIN = false;
    const float* base; float* out; int ldc, pad;
    __device__ __forceinline__ void operator()(const f32x4 (&acc)[2][2][4][2], const Unit& u, int wr, int wc, int fr, int fq) const {
        const int row0 = u.pm * BM + wr * 64 + fr, col0 = u.pn * BM + wc * 32 + 4 * fq;
#pragma unroll
        for (int ai = 0; ai < 2; ++ai)
#pragma unroll
            for (int m = 0; m < 4; ++m) { const size_t off = (size_t)(row0 + ai * HALF + m * 16) * ldc + col0;
#pragma unroll
                for (int bj = 0; bj < 2; ++bj)
#pragma unroll
                    for (int n = 0; n < 2; ++n) { const size_t o = off + bj * HALF + n * 16; *(f32x4*)(out + o) = *(const f32x4*)(base + o) + acc[ai][bj][m][n]; } }
    }
};
__device__ __forceinline__ float silu_mul(float g, float uu) { return g * __builtin_amdgcn_rcpf(1.f + __builtin_amdgcn_exp2f(-1.4426950408889634f * g)) * uu; }
struct EpiSwiglu {
    static constexpr bool PERM = true, AFTER_DRAIN = false;
    bf16_t* H;
    __device__ __forceinline__ void operator()(const f32x4 (&acc)[2][2][4][2], const Unit& u, int wr, int wc, int fr, int fq) const {
        const int row0 = u.pm * BM + wr * 64 + fr, col0 = u.pn * 128 + wc * 32 + 8 * fq;
#pragma unroll
        for (int ai = 0; ai < 2; ++ai)
#pragma unroll
            for (int m = 0; m < 4; ++m) { bf16_t* rowp = H + (size_t)(row0 + ai * HALF + m * 16) * 512 + col0;
                const f32x4 g0 = acc[ai][0][m][0], g1 = acc[ai][0][m][1], u0 = acc[ai][1][m][0], u1 = acc[ai][1][m][1];
                u32x4 w; w.x = cvt_pk_bf16(silu_mul(g0[0], u0[0]), silu_mul(g0[1], u0[1])); w.y = cvt_pk_bf16(silu_mul(g0[2], u0[2]), silu_mul(g0[3], u0[3]));
                w.z = cvt_pk_bf16(silu_mul(g1[0], u1[0]), silu_mul(g1[1], u1[1])); w.w = cvt_pk_bf16(silu_mul(g1[2], u1[2]), silu_mul(g1[3], u1[3]));
                *(u32x4*)rowp = w; }
    }
};

struct EpiQKV {
    static constexpr bool PERM = true, AFTER_DRAIN = false;
    bf16_t* O; const float* cs; float qscale; int pad;
    __device__ __forceinline__ void operator()(const f32x4 (&acc)[2][2][4][2], const Unit& u, int wr, int wc, int fr, int fq) const {
        const int row0 = u.pm * BM + wr * 64 + fr, col0 = u.pn * BM + wc * 32 + 8 * fq;
        const bool rope = (u.pn < 8) && ((wc & 1) == 0);
        const float sc = (u.pn < 4) ? qscale : 1.f;
        const float sgn = (fq == 0) ? -1.f : 1.f; const bool act = fq < 2;
#pragma unroll
        for (int ai = 0; ai < 2; ++ai)
#pragma unroll
            for (int m = 0; m < 4; ++m) { const int row = row0 + ai * HALF + m * 16; bf16_t* rowp = O + (size_t)row * 3072 + col0;
                f32x4 cs0 = {1.f, 0.f, 1.f, 0.f}, cs1 = cs0, cs2 = cs0, cs3 = cs0;
                if (rope) { const f32x4* cp = (const f32x4*)(cs + (size_t)(row & 4095) * 16); cs0 = cp[0]; cs1 = cp[1]; cs2 = cp[2]; cs3 = cp[3]; }
#pragma unroll
                for (int bj = 0; bj < 2; ++bj) { f32x4 v0 = acc[ai][bj][m][0], v1 = acc[ai][bj][m][1];
                    if (rope) {
                        f32x4 p0, p1;
#pragma unroll
                        for (int j = 0; j < 4; ++j) { p0[j] = __shfl_xor(v0[j], 16); p1[j] = __shfl_xor(v1[j], 16); }
                        if (act) {
                            v0[0] = v0[0] * cs0[0] + sgn * p0[0] * cs0[1]; v0[1] = v0[1] * cs0[2] + sgn * p0[1] * cs0[3];
                            v0[2] = v0[2] * cs1[0] + sgn * p0[2] * cs1[1]; v0[3] = v0[3] * cs1[2] + sgn * p0[3] * cs1[3];
                            v1[0] = v1[0] * cs2[0] + sgn * p1[0] * cs2[1]; v1[1] = v1[1] * cs2[2] + sgn * p1[1] * cs2[3];
                            v1[2] = v1[2] * cs3[0] + sgn * p1[2] * cs3[1]; v1[3] = v1[3] * cs3[2] + sgn * p1[3] * cs3[3];
                        }
                    }
                    v0 = v0 * sc; v1 = v1 * sc;
                    u32x4 w; w.x = cvt_pk_bf16(v0[0], v0[1]); w.y = cvt_pk_bf16(v0[2], v0[3]); w.z = cvt_pk_bf16(v1[0], v1[1]); w.w = cvt_pk_bf16(v1[2], v1[3]);
                    *(u32x4*)(rowp + bj * HALF) = w; }
                asm volatile("" ::: "memory"); }
    }
};
struct EpiScaleBf16 {
    static constexpr bool PERM = true, AFTER_DRAIN = false;
    bf16_t* O; const float* rs; int ldc, pad;
    __device__ __forceinline__ void operator()(const f32x4 (&acc)[2][2][4][2], const Unit& u, int wr, int wc, int fr, int fq) const {
        const int row0 = u.pm * BM + wr * 64 + fr, col0 = u.pn * BM + wc * 32 + 8 * fq;
#pragma unroll
        for (int ai = 0; ai < 2; ++ai)
#pragma unroll
            for (int m = 0; m < 4; ++m) { const int row = row0 + ai * HALF + m * 16; const float s = rs[row]; bf16_t* rowp = O + (size_t)row * ldc + col0;
#pragma unroll
                for (int bj = 0; bj < 2; ++bj) { const f32x4 v0 = acc[ai][bj][m][0] * s, v1 = acc[ai][bj][m][1] * s;
                    u32x4 w; w.x = cvt_pk_bf16(v0[0], v0[1]); w.y = cvt_pk_bf16(v0[2], v0[3]); w.z = cvt_pk_bf16(v1[0], v1[1]); w.w = cvt_pk_bf16(v1[2], v1[3]);
                    *(u32x4*)(rowp + bj * HALF) = w; } }
    }
};
struct GroupedOrder {
    const int* ctl; size_t estride; int nN, G, v, pad;
    __device__ __forceinline__ void bind(int G_, int c) { G = G_; v = (G_ % 8 == 0) ? (c % 8) * (G_ / 8) + c / 8 : c; }
    __device__ __forceinline__ bool next(int i, Unit& u) const {
        const int nblk = __builtin_amdgcn_readfirstlane(__hip_atomic_load(ctl + 96, __ATOMIC_RELAXED, __HIP_MEMORY_SCOPE_AGENT));
        const long L = (long)i * G + v; if (L >= (long)nblk * nN) return false;
        u.pm = (int)(L / nN); u.pn = (int)(L % nN);
        u.boff = (size_t)__builtin_amdgcn_readfirstlane(__hip_atomic_load(ctl + 128 + u.pm, __ATOMIC_RELAXED, __HIP_MEMORY_SCOPE_AGENT)) * estride; return true; }
    __device__ __forceinline__ void a_ready(const Unit&) const {}
    __device__ __forceinline__ void done(const Unit&) const {}
};
struct PlainOrder : StaticOrder {
    __device__ __forceinline__ void bind(int G_, int c_) { G = G_; c = c_; }
};
template <class Epi, class Sched, bool ALIGN_EPI = false, bool SP2 = false>
__device__ __forceinline__ void gemm_phase(PG8_LAS unsigned char* lds, const Gemm g, const Sched& S, const Epi& E) {
    const int tid = threadIdx.x, wid = __builtin_amdgcn_readfirstlane(tid >> 6), lane = tid & 63, wr = wid >> 2, wc = wid & 3, fr = lane & 15, fq = lane >> 4;
    const int K = g.K, nt = K / BK;
    unsigned voffA[2], voffB[2];
#pragma unroll
    for (int i = 0; i < 2; ++i) { int R, C; stage_rc(tid * 16 + i * 8192, R, C); const int Rb = Epi::PERM ? ((R & ~31) + perm32(R & 31)) : R;
        voffA[i] = (unsigned)(R * K + C) * 2u; voffB[i] = (unsigned)(Rb * K + C) * 2u; }
    const size_t kstep = (size_t)(BK * 2);
    const size_t hstep = (size_t)HALF * K * 2;
    const size_t tstep = 2 * hstep;
    const unsigned ldsw = (unsigned)wid * 1024u;
    const int aoff = lds_byte(wr * 64 + fr, fq * 8), boff = lds_byte(wc * 32 + fr, fq * 8);
#define PG8_SA(b, h) (((b) * 2 + (h)) * HTB)
#define PG8_SB(b, h) ((4 + (b) * 2 + (h)) * HTB)
#define PG8_STAGE(bufoff, gbase, voff) do { _Pragma("unroll") for (int _i = 0; _i < 2; ++_i) \
        __builtin_amdgcn_global_load_lds((const unsigned*)((const char*)(gbase) + (voff)[_i]), (PG8_LAS unsigned*)(lds + (bufoff) + ldsw + _i * 8192), 16, 0, 0); } while (0)
#define PG8_LDA(dst, b, h) do { _Pragma("unroll") for (int m = 0; m < 4; ++m) _Pragma("unroll") for (int k = 0; k < 2; ++k) dst[m][k] = *(const PG8_LAS bf16x8*)(lds + PG8_SA(b, h) + aoff + m * 2048 + k * 1024); } while (0)
#define PG8_LDB(dst, b, h) do { _Pragma("unroll") for (int n = 0; n < 2; ++n) _Pragma("unroll") for (int k = 0; k < 2; ++k) dst[n][k] = *(const PG8_LAS bf16x8*)(lds + PG8_SB(b, h) + boff + n * 2048 + k * 1024); } while (0)
#define PG8_MMA(ai, bj, At, Bt) do { __builtin_amdgcn_s_setprio(1); _Pragma("unroll") for (int m = 0; m < 4; ++m) _Pragma("unroll") for (int n = 0; n < 2; ++n) _Pragma("unroll") for (int k = 0; k < 2; ++k) \
        acc[ai][bj][m][n] = __builtin_amdgcn_mfma_f32_16x16x32_bf16(Bt[n][k], At[m][k], acc[ai][bj][m][n], 0, 0, 0); __builtin_amdgcn_s_setprio(0); } while (0)
#define PG8_WAIT_V(n) asm volatile("s_waitcnt vmcnt(" #n ")" ::: "memory")
#define PG8_WAIT_L(n) asm volatile("s_waitcnt lgkmcnt(" #n ")" ::: "memory")
#define PG8_BAR __builtin_amdgcn_s_barrier()
#define PG8_SCHED __builtin_amdgcn_sched_barrier(0)
    Unit cur, nxt; int ui = 0;
    if (!S.next(0, cur)) return;
    f32x4 acc[2][2][4][2];
#pragma unroll
    for (int a = 0; a < 2; ++a)
#pragma unroll
        for (int b = 0; b < 2; ++b)
#pragma unroll
            for (int m = 0; m < 4; ++m)
#pragma unroll
                for (int n = 0; n < 2; ++n) acc[a][b][m][n] = (f32x4){0.f, 0.f, 0.f, 0.f};
    bf16x8 At[4][2], B0[2][2], B1[2][2];
    const char* cA = (const char*)g.A + (size_t)cur.pm * tstep; const char* cB = (const char*)g.Bt + cur.boff + (size_t)cur.pn * tstep;
    S.a_ready(cur);
    if constexpr (SP2) {
        PG8_STAGE(PG8_SB(0, 0), cB, voffB); PG8_STAGE(PG8_SB(0, 1), cB + hstep, voffB); PG8_STAGE(PG8_SA(0, 0), cA, voffA); PG8_STAGE(PG8_SA(0, 1), cA + hstep, voffA);
        if (wr == 1) PG8_BAR;
        PG8_WAIT_V(2); PG8_BAR;
        PG8_STAGE(PG8_SB(1, 0), cB + kstep, voffB); PG8_STAGE(PG8_SA(1, 0), cA + kstep, voffA); PG8_STAGE(PG8_SB(1, 1), cB + hstep + kstep, voffB);
        PG8_WAIT_V(6); PG8_BAR;
    } else {
        PG8_STAGE(PG8_SB(0, 0), cB, voffB); PG8_STAGE(PG8_SA(0, 0), cA, voffA); PG8_STAGE(PG8_SB(0, 1), cB + hstep, voffB); PG8_STAGE(PG8_SA(0, 1), cA + hstep, voffA);
        if (wr == 1) PG8_BAR;
        PG8_WAIT_V(4); PG8_BAR;
        PG8_STAGE(PG8_SB(1, 0), cB + kstep, voffB); PG8_STAGE(PG8_SA(1, 0), cA + kstep, voffA); PG8_STAGE(PG8_SB(1, 1), cB + hstep + kstep, voffB);
        PG8_WAIT_V(6); PG8_BAR;
    }
    for (;;) {
        const bool has_next = S.next(ui + 1, nxt);
        const char* nA = has_next ? (const char*)g.A + (size_t)nxt.pm * tstep : cA; const char* nB = has_next ? (const char*)g.Bt + nxt.boff + (size_t)nxt.pn * tstep : cB;
        for (int t = 0; t < nt; t += 2) {
            const bool last = (t == nt - 2);
            const char* a1 = cA + (size_t)(t + 1) * kstep;
            const char* a2 = last ? nA : cA + (size_t)(t + 2) * kstep; const char* b2 = last ? nB : cB + (size_t)(t + 2) * kstep;
            const char* a3 = a2 + kstep; const char* b3 = b2 + kstep;
            if (last && has_next) S.a_ready(nxt);
            if constexpr (SP2) {
            PG8_LDB(B0, 0, 0); PG8_LDB(B1, 0, 1); PG8_SCHED; PG8_LDA(At, 0, 0); PG8_STAGE(PG8_SA(1, 1), a1 + hstep, voffA);
            PG8_WAIT_V(8); PG8_WAIT_L(0); PG8_BAR; PG8_MMA(0, 0, At, B0); PG8_MMA(0, 1, At, B1); PG8_BAR; PG8_SCHED;
            PG8_LDA(At, 0, 1); PG8_STAGE(PG8_SB(0, 0), b2, voffB); PG8_STAGE(PG8_SB(0, 1), b2 + hstep, voffB); PG8_STAGE(PG8_SA(0, 0), a2, voffA);
            PG8_WAIT_V(8); PG8_WAIT_L(0); PG8_BAR; PG8_MMA(1, 0, At, B0); PG8_MMA(1, 1, At, B1); PG8_BAR; PG8_SCHED;
            PG8_LDB(B0, 1, 0); PG8_LDB(B1, 1, 1); PG8_SCHED; PG8_LDA(At, 1, 0); PG8_STAGE(PG8_SA(0, 1), a2 + hstep, voffA);
            PG8_WAIT_V(8); PG8_WAIT_L(0); PG8_BAR; PG8_MMA(0, 0, At, B0); PG8_MMA(0, 1, At, B1); PG8_BAR; PG8_SCHED;
            PG8_LDA(At, 1, 1); PG8_STAGE(PG8_SB(1, 0), b3, voffB); PG8_STAGE(PG8_SB(1, 1), b3 + hstep, voffB); PG8_STAGE(PG8_SA(1, 0), a3, voffA);
            PG8_WAIT_V(8); PG8_WAIT_L(0); PG8_BAR; PG8_MMA(1, 0, At, B0); PG8_MMA(1, 1, At, B1); PG8_BAR; PG8_SCHED;
            } else {
            PG8_LDB(B0, 0, 0); PG8_SCHED; PG8_LDA(At, 0, 0); PG8_STAGE(PG8_SA(1, 1), a1 + hstep, voffA);
            PG8_WAIT_L(8); PG8_BAR; PG8_WAIT_L(0); PG8_MMA(0, 0, At, B0); PG8_BAR; PG8_SCHED;
            PG8_LDB(B1, 0, 1); PG8_STAGE(PG8_SB(0, 0), b2, voffB);
            PG8_BAR; PG8_WAIT_L(0); PG8_MMA(0, 1, At, B1); PG8_BAR;
            PG8_LDA(At, 0, 1); PG8_STAGE(PG8_SA(0, 0), a2, voffA);
            PG8_BAR; PG8_WAIT_L(0); PG8_MMA(1, 0, At, B0); PG8_BAR; PG8_SCHED;
            PG8_STAGE(PG8_SB(0, 1), b2 + hstep, voffB);
            PG8_WAIT_V(6); PG8_BAR; PG8_MMA(1, 1, At, B1); PG8_BAR;
            PG8_LDB(B0, 1, 0); PG8_SCHED; PG8_LDA(At, 1, 0); PG8_STAGE(PG8_SA(0, 1), a2 + hstep, voffA);
            PG8_WAIT_L(8); PG8_BAR; PG8_WAIT_L(0); PG8_MMA(0, 0, At, B0); PG8_BAR; PG8_SCHED;
            PG8_LDB(B1, 1, 1); PG8_STAGE(PG8_SB(1, 0), b3, voffB);
            PG8_BAR; PG8_WAIT_L(0); PG8_MMA(0, 1, At, B1); PG8_BAR;
            PG8_LDA(At, 1, 1); PG8_STAGE(PG8_SA(1, 0), a3, voffA);
            PG8_BAR; PG8_WAIT_L(0); PG8_MMA(1, 0, At, B0); PG8_BAR; PG8_SCHED;
            PG8_STAGE(PG8_SB(1, 1), b3 + hstep, voffB);
            PG8_WAIT_V(6); PG8_BAR; PG8_MMA(1, 1, At, B1); PG8_BAR;
            }
        }
        if constexpr (ALIGN_EPI) { if (wr == 0) PG8_BAR; }
        if constexpr (!Epi::AFTER_DRAIN) { E(acc, cur, wr, wc, fr, fq); S.done(cur); }
        if (!has_next) break;
#pragma unroll
        for (int a = 0; a < 2; ++a)
#pragma unroll
            for (int b = 0; b < 2; ++b)
#pragma unroll
                for (int m = 0; m < 4; ++m)
#pragma unroll
                    for (int n = 0; n < 2; ++n) acc[a][b][m][n] = (f32x4){0.f, 0.f, 0.f, 0.f};
        cur = nxt; cA = nA; cB = nB; ++ui;
        if constexpr (ALIGN_EPI) { if (wr == 1) PG8_BAR; }
    }
    PG8_WAIT_V(0);
    if constexpr (!ALIGN_EPI) { if (wr == 0) PG8_BAR; }
    PG8_BAR;
    if constexpr (Epi::AFTER_DRAIN) { E.fused(acc, cur, wr, wc, fr, fq, lds, wid, lane); S.done(cur); }
#undef PG8_SA
#undef PG8_SB
#undef PG8_STAGE
#undef PG8_LDA
#undef PG8_LDB
#undef PG8_MMA
#undef PG8_WAIT_V
#undef PG8_WAIT_L
#undef PG8_BAR
#undef PG8_SCHED
}
}
#include <hip/hip_bf16.h>
#include <cmath>
namespace attn_body {
using bf16=__hip_bfloat16;
using bf16x8=__attribute__((ext_vector_type(8)))short;
using s16x4=__attribute__((ext_vector_type(4)))short;
using f32x16=__attribute__((ext_vector_type(16)))float;
using u32x4=__attribute__((ext_vector_type(4)))unsigned;
constexpr int BATCH=4,NHEAD=32,SEQ=4096,D=64,DM=3072,DMO=2048;
constexpr int NW=8,QBLK=32,QB=QBLK*NW,KVBLK=64,NQB=SEQ/QB;
constexpr int ATTN_PITCH=DM, ATTN_UNIT_ROWS=QB;
__device__ __forceinline__ int crow(int r,int hi){return (r&3)+8*(r>>2)+4*hi;}
#define SBAR() __builtin_amdgcn_sched_barrier(0)
__device__ __forceinline__ void cmask(f32x16&p0,f32x16&p1,int jb,int qrel,int hi){
  const float NEG=-INFINITY; int kb=64*jb+4*hi;
  #pragma unroll
  for(int r=0;r<16;++r){int kv=kb+(r&3)+8*(r>>2); if(kv>qrel)p0[r]=NEG; if(kv+32>qrel)p1[r]=NEG;}
}

constexpr int NSLOT=3, SLOTB=8192;
constexpr int LDS_K=0, LDS_V=NSLOT*SLOTB, LDS_WS=2*NSLOT*SLOTB, LDS_OST=LDS_WS+NW*64*4, LDS_BYTES=LDS_OST+NW*4096;
constexpr float C2=0.125f*1.4426950408889634f;
__device__ __forceinline__ void glds16(const void*gsrc,unsigned lds_dst){unsigned keep;
  asm volatile("s_mov_b32 %0, m0\n\ts_mov_b32 m0, %2\n\ts_nop 0\n\tglobal_load_lds_dwordx4 %1, off\n\ts_mov_b32 m0, %0":"=&s"(keep):"v"(gsrc),"s"(lds_dst):"memory");}
__device__ __forceinline__ float max3f(float a,float b,float c){float r;asm("v_max3_f32 %0, %1, %2, %3":"=v"(r):"v"(a),"v"(b),"v"(c));return r;}
__device__ __forceinline__ float max2f(float a,float b){float r;asm("v_max_f32_e32 %0, %1, %2":"=v"(r):"v"(a),"v"(b));return r;}
__device__ __forceinline__ float fadd_s(float a,float b){float r;asm("v_add_f32_e32 %0, %1, %2":"=v"(r):"v"(a),"v"(b));return r;}
__device__ __forceinline__ float fsub_s(float a,float b){float r;asm("v_sub_f32_e32 %0, %1, %2":"=v"(r):"v"(a),"v"(b));return r;}
typedef float f32x2_t __attribute__((ext_vector_type(2))); typedef __bf16 bf16x2_t __attribute__((ext_vector_type(2)));
__device__ __forceinline__ unsigned cvtpk_s(float lo,float hi){f32x2_t v={lo,hi};bf16x2_t b=__builtin_convertvector(v,bf16x2_t);return __builtin_bit_cast(unsigned,b);}
#define WAIT_BAR(N) asm volatile("s_waitcnt vmcnt(" #N ") lgkmcnt(0)\n\ts_barrier":::"memory")

__device__ __forceinline__ void qkt(f32x16&p0,f32x16&p1,const char*Kslot,const bf16x8*qr,const f32x16&negm,int r32,int hi){
  const char*kb=Kslot+hi*1024+r32*16;
  #pragma unroll
  for(int d0=0;d0<4;++d0){
    const bf16x8 b0=*reinterpret_cast<const bf16x8*>(kb+d0*2048);
    const bf16x8 b1=*reinterpret_cast<const bf16x8*>(kb+d0*2048+512);
    if(d0==0){p0=__builtin_amdgcn_mfma_f32_32x32x16_bf16(b0,qr[0],negm,0,0,0);p1=__builtin_amdgcn_mfma_f32_32x32x16_bf16(b1,qr[0],negm,0,0,0);}
    else{p0=__builtin_amdgcn_mfma_f32_32x32x16_bf16(b0,qr[d0],p0,0,0,0);p1=__builtin_amdgcn_mfma_f32_32x32x16_bf16(b1,qr[d0],p1,0,0,0);}}
}
typedef __attribute__((address_space(3))) const char* lds_cptr;
typedef short v4i16_t __attribute__((ext_vector_type(4)));
__device__ __forceinline__ void kload8(bf16x8*kf,lds_cptr kp){
  kf[0]=*(const __attribute__((address_space(3))) bf16x8*)(kp);      kf[1]=*(const __attribute__((address_space(3))) bf16x8*)(kp+512);
  kf[2]=*(const __attribute__((address_space(3))) bf16x8*)(kp+2048); kf[3]=*(const __attribute__((address_space(3))) bf16x8*)(kp+2560);
  kf[4]=*(const __attribute__((address_space(3))) bf16x8*)(kp+4096); kf[5]=*(const __attribute__((address_space(3))) bf16x8*)(kp+4608);
  kf[6]=*(const __attribute__((address_space(3))) bf16x8*)(kp+6144); kf[7]=*(const __attribute__((address_space(3))) bf16x8*)(kp+6656);
}
__device__ __forceinline__ void kload2(bf16x8*kf,lds_cptr kp,int j){ kf[2*j]=*(const __attribute__((address_space(3))) bf16x8*)(kp+j*2048); kf[2*j+1]=*(const __attribute__((address_space(3))) bf16x8*)(kp+j*2048+512); }
__device__ __forceinline__ s16x4 vtr(lds_cptr p){ return __builtin_bit_cast(s16x4,__builtin_amdgcn_ds_read_tr16_b64_v4i16((__attribute__((address_space(3))) v4i16_t*)p)); }
__device__ __forceinline__ float rowmax(const f32x16&p0,const f32x16&p1){
  float a=max3f(p0[0],p0[1],p1[0]),b=max3f(p0[2],p0[3],p1[1]);a=max3f(a,p1[2],p1[3]);
  #pragma unroll
  for(int r=4;r<16;r+=4){a=max3f(a,p0[r],p0[r+1]);b=max3f(b,p0[r+2],p0[r+3]);a=max3f(a,p1[r],p1[r+1]);b=max3f(b,p1[r+2],p1[r+3]);}
  const float m=max2f(a,b);
  auto rr=__builtin_amdgcn_permlane32_swap(__float_as_uint(m),__float_as_uint(m),false,false);
  return max2f(__uint_as_float(rr[0]),__uint_as_float(rr[1]));
}
__device__ __forceinline__ void pv(f32x16*o,int vb,bf16x8 pa0,bf16x8 pa1,bf16x8 pa2,bf16x8 pa3){
  #pragma unroll
  for(int d0=0;d0<2;++d0){s16x4 lo[4],hi[4];
    #pragma unroll
    for(int ks=0;ks<4;++ks){
      asm volatile("ds_read_b64_tr_b16 %0,%1 offset:%c2":"=&v"(lo[ks]):"v"(vb),"i"(d0*4096+ks*1024):"memory");
      asm volatile("ds_read_b64_tr_b16 %0,%1 offset:%c2":"=&v"(hi[ks]):"v"(vb),"i"(d0*4096+ks*1024+512):"memory");}
    asm volatile("s_waitcnt lgkmcnt(0)":::"memory");SBAR();
    #define PK(k) (bf16x8){lo[k][0],lo[k][1],lo[k][2],lo[k][3],hi[k][0],hi[k][1],hi[k][2],hi[k][3]}
    o[d0]=__builtin_amdgcn_mfma_f32_32x32x16_bf16(pa0,PK(0),o[d0],0,0,0);
    o[d0]=__builtin_amdgcn_mfma_f32_32x32x16_bf16(pa1,PK(1),o[d0],0,0,0);
    o[d0]=__builtin_amdgcn_mfma_f32_32x32x16_bf16(pa2,PK(2),o[d0],0,0,0);
    o[d0]=__builtin_amdgcn_mfma_f32_32x32x16_bf16(pa3,PK(3),o[d0],0,0,0);
    #undef PK
  }
}

#ifndef ATTN_STORE16
#define ATTN_STORE16(p,v) (*(u32x4*)(p)=(v))
#endif
template<int THRL> __device__ __forceinline__ void attn_unit(int b,int h,int qb,const bf16*Q,const bf16*__restrict__ K,const bf16*__restrict__ V,bf16*O,char*shm){
  const int tid=threadIdx.x,lane=tid&63,r32=lane&31,hi=lane>>5; const int wid=__builtin_amdgcn_readfirstlane(tid>>6);
  const long rowbase=(long)b*SEQ; const int q0=qb*QB;
  const bf16*Qw=Q+(rowbase+q0+wid*QBLK)*DM+(h>>1)*D;
  const bf16*Kh=K+rowbase*DM+(h>>1)*D,*Vh=V+rowbase*DM+((h>>2)*2+(h&1))*D;
  const unsigned lds0=(unsigned)(uintptr_t)shm;
  float*wsf=(float*)(shm+LDS_WS)+wid*64;
  const bf16*ksrc=Kh+(long)lane*DM+wid*8;
  const bf16*vsrc=Vh+(long)(16*(wid&3)+(lane>>2))*DM+(wid>>2)*32+(lane&3)*8;
  const unsigned kdst=lds0+LDS_K+wid*1024, vdst=lds0+LDS_V+wid*1024;
  #define DMA_K(t,slot) glds16(ksrc+(long)(t)*KVBLK*DM,(unsigned)__builtin_amdgcn_readfirstlane(kdst+(slot)))
  #define DMA_V(t,slot) glds16(vsrc+(long)(t)*KVBLK*DM,(unsigned)__builtin_amdgcn_readfirstlane(vdst+(slot)))
  const int vb0=(int)(lds0+LDS_V)+((lane>>4)&1)*32+(lane&3)*8+(4*hi+((lane&15)>>2))*64;
  const char*Kbase=shm+LDS_K; bf16x8 kf[8];
  const lds_cptr shm3=(lds_cptr)shm; const lds_cptr kp0=shm3+LDS_K+hi*1024+r32*16; const lds_cptr vp0=shm3+LDS_V+((lane>>4)&1)*32+(lane&3)*8+(4*hi+((lane&15)>>2))*64;
  const int NT=(q0+QB)/KVBLK;
  DMA_K(0,0);DMA_V(0,0);DMA_K(1,SLOTB);
  bf16x8 qr[4];
  #pragma unroll
  for(int d0=0;d0<4;++d0)qr[d0]=*reinterpret_cast<const bf16x8*>(&Qw[(long)r32*DM+d0*16+hi*8]);
  float mhat=0.f,l_reg=0.f;f32x16 o[2];o[0]=f32x16{};o[1]=f32x16{};f32x16 negm=f32x16{};asm volatile("":"+v"(negm));
  const int qrel=wid*QBLK+r32;
  #define CMASK(P0,P1,t) do{int jb_=(t)-(NT-4); if(jb_>=0)cmask(P0,P1,jb_,qrel,hi);}while(0)
  bool resc=false;
  #define START(P0,P1) do{ const float rm=rowmax(P0,P1); resc=false; \
    { const float dl=rm; mhat=fadd_s(mhat,dl); \
      _Pragma("unroll") for(int r=0;r<16;++r){P0[r]=fsub_s(P0[r],dl);P1[r]=fsub_s(P1[r],dl);} \
      _Pragma("unroll") for(int r=0;r<16;++r)negm[r]=-mhat; asm volatile("":"+v"(negm)); } \
    _Pragma("unroll") for(int r=0;r<16;++r)P0[r]=__builtin_amdgcn_exp2f(P0[r]); }while(0)
  #define RESC() do{ if(resc){ asm volatile("s_waitcnt lgkmcnt(0)":::"memory"); \
      _Pragma("unroll") for(int d_=0;d_<2;++d_) _Pragma("unroll") for(int r=0;r<16;++r)o[d_][r]*=wsf[crow(r,hi)]; } }while(0)
  f32x16 pA0,pA1,pB0,pB1;
  int sl_prev=0,sl_cur=0,sl_next=SLOTB;
  #define ROT() do{sl_prev=sl_cur;sl_cur=sl_next;sl_next=(sl_next==(NSLOT-1)*SLOTB)?0:sl_next+SLOTB;}while(0)
  DMA_K(2,2*SLOTB);
  WAIT_BAR(3);
  qkt(pA0,pA1,Kbase,qr,negm,r32,hi);asm volatile("s_nop 15\n\ts_nop 7":"+v"(pA0),"+v"(pA1));CMASK(pA0,pA1,0);
  START(pA0,pA1);
  _Pragma("unroll") for(int r=0;r<16;++r)pA1[r]=__builtin_amdgcn_exp2f(pA1[r]);
  WAIT_BAR(0);
  DMA_K(3,0);DMA_V(1,SLOTB);
  ROT();
  kload8(kf,kp0+sl_cur);
  WAIT_BAR(2);
  s16x4 vlo[8],vhi[8]; u32x4 pw0,pw1,pw2,pw3;
  #define PKW(P,B) cvtpk_s(P[B],P[B+1])
  #define PAF(k) __builtin_bit_cast(bf16x8,pw##k)
  #define VFR(i) (bf16x8){vlo[i][0],vlo[i][1],vlo[i][2],vlo[i][3],vhi[i][0],vhi[i][1],vhi[i][2],vhi[i][3]}
  #define PIN(x) asm volatile("":"+v"(x))
  #define MX3(a,b,c) __builtin_fmaxf(__builtin_fmaxf((a),(b)),(c))
  #define GAPA(MF,A0,A1,A2,A3,W0,W1,PW) do{ MF; sacc+=A0; sacc+=A1; sacc+=A2; sacc+=A3; PIN(sacc); W0; W1; PIN(PW); SBAR(); }while(0)
  #define EX(v) __builtin_amdgcn_exp2f(v)
  #define GAPB(MF,X,B) do{ MF; X[B]=EX(X[B]); X[B+1]=EX(X[B+1]); X[B+2]=EX(X[B+2]); X[B+3]=EX(X[B+3]); PIN(X); SBAR(); }while(0)
  #define VRD(i) do{ vlo[i]=vtr(vp_+(((i)>>2)*4096+((i)&3)*1024)); vhi[i]=vtr(vp_+(((i)>>2)*4096+((i)&3)*1024+512)); }while(0)
  #define KRD(G,j) do{ if(G){ kload2(kf,kp0+sl_next,j); SBAR(); } }while(0)
  #define STEP(C0,C1,P0,P1,t,GK,GV,GL) do{ SBAR(); \
    const lds_cptr vp_=vp0+sl_prev; \
    VRD(0); SBAR(); float sacc=(P0[0]+P0[1]); \
    GAPA(C0=__builtin_amdgcn_mfma_f32_32x32x16_bf16(kf[0],qr[0],negm,0,0,0), P0[2],P0[3],P0[4],P0[5],     pw0[0]=PKW(P0,0), pw0[1]=PKW(P0,2), pw0); \
    VRD(4); SBAR(); GAPA(C1=__builtin_amdgcn_mfma_f32_32x32x16_bf16(kf[1],qr[0],negm,0,0,0), P0[6],P0[7],P0[8],P0[9],     pw0[2]=PKW(P0,4), pw0[3]=PKW(P0,6), pw0); \
    VRD(1); SBAR(); GAPA(C0=__builtin_amdgcn_mfma_f32_32x32x16_bf16(kf[2],qr[1],C0,0,0,0),   P0[10],P0[11],P0[12],P0[13], pw1[0]=PKW(P0,8), pw1[1]=PKW(P0,10), pw1); \
    VRD(5); SBAR(); GAPA(C1=__builtin_amdgcn_mfma_f32_32x32x16_bf16(kf[3],qr[1],C1,0,0,0),   P0[14],P0[15],P1[0],P1[1],   pw1[2]=PKW(P0,12),pw1[3]=PKW(P0,14), pw1); \
    VRD(2); SBAR(); GAPA(C0=__builtin_amdgcn_mfma_f32_32x32x16_bf16(kf[4],qr[2],C0,0,0,0),   P1[2],P1[3],P1[4],P1[5],     pw2[0]=PKW(P1,0), pw2[1]=PKW(P1,2), pw2); \
    VRD(6); SBAR(); GAPA(C1=__builtin_amdgcn_mfma_f32_32x32x16_bf16(kf[5],qr[2],C1,0,0,0),   P1[6],P1[7],P1[8],P1[9],     pw2[2]=PKW(P1,4), pw2[3]=PKW(P1,6), pw2); \
    VRD(3); SBAR(); GAPA(C0=__builtin_amdgcn_mfma_f32_32x32x16_bf16(kf[6],qr[3],C0,0,0,0),   P1[10],P1[11],P1[12],P1[13], pw3[0]=PKW(P1,8), pw3[1]=PKW(P1,10), pw3); \
    VRD(7); SBAR(); GAPA(C1=__builtin_amdgcn_mfma_f32_32x32x16_bf16(kf[7],qr[3],C1,0,0,0),   P1[14],P1[15],0.f,0.f,       pw3[2]=PKW(P1,12),pw3[3]=PKW(P1,14), pw3); \
    l_reg+=sacc; \
    if(GK){DMA_K((t)+3,sl_cur);} if(GV){DMA_V((t)+1,sl_next);} \
    CMASK(C0,C1,t); \
    { float a=MX3(C0[0],C0[1],C1[0]),b=MX3(C0[2],C0[3],C1[1]); a=MX3(a,C1[2],C1[3]); \
      _Pragma("unroll") for(int r=4;r<16;r+=4){a=MX3(a,C0[r],C0[r+1]);b=MX3(b,C0[r+2],C0[r+3]);a=MX3(a,C1[r],C1[r+1]);b=MX3(b,C1[r+2],C1[r+3]);} \
      float rm=__builtin_fmaxf(a,b); { auto rr=__builtin_amdgcn_permlane32_swap(__float_as_uint(rm),__float_as_uint(rm),false,false); rm=__builtin_fmaxf(__uint_as_float(rr[0]),__uint_as_float(rr[1])); } \
      resc=false; \
      if(__builtin_expect(__any(rm>(float)THRL),0)){ const float dl=__builtin_fmaxf(rm,0.f); mhat+=dl; \
        _Pragma("unroll") for(int r=0;r<16;++r){C0[r]-=dl;C1[r]-=dl;} \
        _Pragma("unroll") for(int r=0;r<16;++r)negm[r]=-mhat; asm volatile("":"+v"(negm)); \
        const float f=__builtin_amdgcn_exp2f(-dl); l_reg*=f; if(hi==0)wsf[r32]=f; resc=true; } } \
    SBAR(); \
    GAPB(o[0]=__builtin_amdgcn_mfma_f32_32x32x16_bf16(PAF(0),VFR(0),o[0],0,0,0), C0,0); \
    GAPB(o[1]=__builtin_amdgcn_mfma_f32_32x32x16_bf16(PAF(0),VFR(4),o[1],0,0,0), C0,4); \
    KRD(GL,0); GAPB(o[0]=__builtin_amdgcn_mfma_f32_32x32x16_bf16(PAF(1),VFR(1),o[0],0,0,0), C0,8); \
    KRD(GL,1); GAPB(o[1]=__builtin_amdgcn_mfma_f32_32x32x16_bf16(PAF(1),VFR(5),o[1],0,0,0), C0,12); \
    KRD(GL,2); GAPB(o[0]=__builtin_amdgcn_mfma_f32_32x32x16_bf16(PAF(2),VFR(2),o[0],0,0,0), C1,0); \
    KRD(GL,3); GAPB(o[1]=__builtin_amdgcn_mfma_f32_32x32x16_bf16(PAF(2),VFR(6),o[1],0,0,0), C1,4); \
    GAPB(o[0]=__builtin_amdgcn_mfma_f32_32x32x16_bf16(PAF(3),VFR(3),o[0],0,0,0), C1,8); \
    GAPB(o[1]=__builtin_amdgcn_mfma_f32_32x32x16_bf16(PAF(3),VFR(7),o[1],0,0,0), C1,12); \
    }while(0)
  int t=1;
  #undef CMASK
  #define CMASK(P0,P1,t) do{}while(0)
  for(;t+5<NT;t+=2){
    STEP(pB0,pB1,pA0,pA1,t,true,true,true);     WAIT_BAR(2); RESC(); ROT();
    STEP(pA0,pA1,pB0,pB1,t+1,true,true,true);   WAIT_BAR(2); RESC(); ROT();
  }
  #undef CMASK
  #define CMASK(P0,P1,t) do{int jb_=(t)-(NT-4); if(jb_>=0)cmask(P0,P1,jb_,qrel,hi);}while(0)
  #define ENDW(tt) do{ if((tt)+3<NT){WAIT_BAR(2);} else if((tt)+2<NT){WAIT_BAR(1);} else {WAIT_BAR(0);} }while(0)
  for(;t+1<NT;t+=2){
    STEP(pB0,pB1,pA0,pA1,t,(t+3<NT),(t+1<NT),(t+1<NT));       ENDW(t);   RESC(); ROT();
    STEP(pA0,pA1,pB0,pB1,t+1,(t+4<NT),(t+2<NT),(t+2<NT));     ENDW(t+1); RESC(); ROT();
  }
  STEP(pB0,pB1,pA0,pA1,NT-1,false,false,false); RESC();
  { float sacc=pB0[0]+pB0[1]; _Pragma("unroll") for(int r=2;r<16;++r)sacc+=pB0[r]; _Pragma("unroll") for(int r=0;r<16;++r)sacc+=pB1[r]; l_reg+=sacc;
    pw0=(u32x4){PKW(pB0,0),PKW(pB0,2),PKW(pB0,4),PKW(pB0,6)};pw1=(u32x4){PKW(pB0,8),PKW(pB0,10),PKW(pB0,12),PKW(pB0,14)};pw2=(u32x4){PKW(pB1,0),PKW(pB1,2),PKW(pB1,4),PKW(pB1,6)};pw3=(u32x4){PKW(pB1,8),PKW(pB1,10),PKW(pB1,12),PKW(pB1,14)};
    SBAR(); pv(o,vb0+sl_cur,PAF(0),PAF(1),PAF(2),PAF(3)); }
  #undef PKW
  #undef PAF
  #undef VFR
  #undef PIN
  #undef MX3
  #undef GAPA
  #undef GAPB
  #undef EX
  #undef VRD
  #undef KRD
  #undef STEP
  #undef ENDW
  {auto rr=__builtin_amdgcn_permlane32_swap(__float_as_uint(l_reg),__float_as_uint(l_reg),false,false);l_reg=__uint_as_float(rr[0])+__uint_as_float(rr[1]);}
  if(hi==0)wsf[32+r32]=l_reg;asm volatile("s_waitcnt lgkmcnt(0)":::"memory");
  float rli[16];
  #pragma unroll
  for(int r=0;r<16;++r)rli[r]=__builtin_amdgcn_rcpf(wsf[32+crow(r,hi)]);
  bf16*Ow=O+(rowbase+q0+wid*QBLK)*DMO+h*D;
  { bf16*stg=(bf16*)(shm+LDS_OST)+wid*2048;
    #pragma unroll
    for(int r=0;r<16;++r){const int orow=crow(r,hi);
      #pragma unroll
      for(int d0=0;d0<2;++d0)stg[orow*64+d0*32+r32]=__float2bfloat16(o[d0][r]*rli[r]);}
    asm volatile("s_waitcnt lgkmcnt(0)":::"memory");
    #pragma unroll
    for(int i=0;i<4;++i){const int row=i*8+(lane>>3),ch=lane&7; const u32x4 v=*(const u32x4*)(stg+row*64+ch*8); ATTN_STORE16(Ow+(long)row*DMO+ch*8,v);} }
  asm volatile("s_waitcnt lgkmcnt(0)\n\ts_barrier":::"memory");
  #undef DMA_K
  #undef DMA_V
  #undef CMASK
  #undef START
  #undef RESC
  #undef ROT
}
constexpr int ATTN_LDS_BYTES=LDS_BYTES;
struct AttnTensors { const bf16* Q; const bf16* K; const bf16* V; bf16* O; };
struct AttnUnit { int bh; int qb; };
struct StaticOrder {
  int vcu;
  __device__ __forceinline__ explicit StaticOrder(int grid,int block):vcu((grid%8==0)?((block%8)*(grid/8)+block/8):block){}
  __device__ __forceinline__ bool next(int i,AttnUnit&u)const{ if(i>=8)return false; const int s=4*(vcu&1)+(i>>1); u.bh=vcu>>1; u.qb=(i&1)?15-s:s; return true; }
  __device__ __forceinline__ void a_ready(const AttnUnit&)const{}
  __device__ __forceinline__ void done(const AttnUnit&)const{}
};
template<class Sched,int THRL=8> __device__ __forceinline__ void attn_phase(char*lds,const AttnTensors&T,const Sched&S){
  AttnUnit u;
  for(int i=0;S.next(i,u);++i){ S.a_ready(u); attn_unit<THRL>(u.bh/NHEAD,u.bh%NHEAD,u.qb,T.Q,T.K,T.V,T.O,lds); S.done(u); }
}
#undef SBAR
#undef WAIT_BAR
}
namespace {
typedef short bf16x8_t __attribute__((ext_vector_type(8)));
typedef float f32x16_t __attribute__((ext_vector_type(16)));
typedef float f32x4_t __attribute__((ext_vector_type(4)));
typedef float f32x2_t __attribute__((ext_vector_type(2)));

constexpr size_t MiB = 1u << 20;
constexpr size_t WS_CTL = 0, CTL_ZERO_BYTES = 1 * MiB;
constexpr size_t WS_WIN = 1 * MiB;
constexpr size_t WS_WOUT = 6 * MiB;
constexpr size_t WS_WQKV = 8 * MiB;
constexpr size_t WS_CWOUT = 14 * MiB;
constexpr size_t WS_SMALLW = 16 * MiB;
constexpr size_t WS_MISC = 17 * MiB;
constexpr size_t WS_XN = 19 * MiB;
constexpr size_t WS_BIG = 51 * MiB;
constexpr size_t WS_W1T = 147 * MiB;
constexpr size_t WS_W2T = 275 * MiB;
constexpr size_t WS_R3 = 339 * MiB;
constexpr size_t WS_Y = 459 * MiB;
constexpr size_t WS_G = 491 * MiB;
constexpr size_t WS_END = 507 * MiB;
constexpr int CW_MOE0 = 0, CW_MOE1 = 4096, CW_BAR = 8192;
constexpr int MOE_PLAN = 2048;
constexpr int LDS_BYTES = 155648;
constexpr int MISC_OFF = 151552;

#define XB_TMO      128
#define XB_XCNT(j)  (256  + 64 * (j))
#define XB_XSUB(j)  (1280 + 64 * (j))
#define XB_XGEN(j)  (2304 + 64 * (j))
#define XB_TOP      3328
#define XB_TOPGEN   3392
#define XCD_BAR_WORDS 3456
#define XB_SPIN_CAP (1u << 18)

__device__ __forceinline__ unsigned xb_ld(unsigned* p)              { return __hip_atomic_load(p, __ATOMIC_RELAXED, __HIP_MEMORY_SCOPE_AGENT); }
__device__ __forceinline__ unsigned xb_add(unsigned* p, unsigned v) { return __hip_atomic_fetch_add(p, v, __ATOMIC_RELAXED, __HIP_MEMORY_SCOPE_AGENT); }
__device__ __forceinline__ unsigned xb_xcc_id() { return (unsigned)__builtin_amdgcn_s_getreg((3 << 11) | 20) & 0xFu; }
#define XB_SPIN(cond, bar) do { unsigned _sp = 0; while (cond) { __builtin_amdgcn_s_sleep(1); \
    if ((++_sp & 255u) == 0u) { if (xb_ld(&(bar)[XB_TMO])) break; if (_sp > XB_SPIN_CAP) { atomicAdd(&(bar)[XB_TMO], 1u); break; } } } } while (0)

struct XcdBarrier {
    unsigned* bar; unsigned x;
    volatile LAS unsigned* st;
};

__device__ __forceinline__ XcdBarrier xcd_barrier_post(unsigned* bar, volatile LAS unsigned* st) {
    XcdBarrier b; b.bar = bar; b.x = xb_xcc_id(); b.st = st;
    if (threadIdx.x == 0) (void)xb_add(&bar[XB_XCNT(b.x)], 1u);
    return b;
}
__device__ __forceinline__ void xcd_barrier_complete(unsigned* bar, unsigned x, unsigned& nloc, unsigned& nx) {
    const unsigned G = gridDim.x * gridDim.y * gridDim.z;
    unsigned sum, cnt, mine, sp = 0u;
    for (;;) {
        sum = 0u; cnt = 0u; mine = 0u;
#pragma unroll
        for (unsigned j = 0; j < 16; ++j) { const unsigned c = xb_ld(&bar[XB_XCNT(j)]); sum += c; cnt += (c > 0u) ? 1u : 0u; mine = (j == x) ? c : mine; }
        if (sum == G) break;
        __builtin_amdgcn_s_sleep(1);
        if ((++sp & 255u) == 0u) { if (xb_ld(&bar[XB_TMO])) break; if (sp > XB_SPIN_CAP) { atomicAdd(&bar[XB_TMO], 1u); break; } }
    }
    nloc = mine > 0u ? mine : 1u; nx = cnt > 0u ? cnt : 1u;
}

__device__ __forceinline__ void xcd_barrier(const XcdBarrier& b) {
    asm volatile("s_waitcnt vmcnt(0)" ::: "memory");
    __syncthreads();
    if (threadIdx.x == 0) {
        unsigned* bar = b.bar;
        __builtin_amdgcn_s_waitcnt(0);
        unsigned nloc = b.st[0], nx = b.st[1];
        if (nloc == 0u) { xcd_barrier_complete(bar, b.x, nloc, nx); b.st[0] = nloc; b.st[1] = nx; }
        const unsigned old = xb_add(&bar[XB_XSUB(b.x)], 1u);
        const unsigned gen = old / nloc;
        if (old + 1u == (gen + 1u) * nloc) {
            __builtin_amdgcn_fence(__ATOMIC_RELEASE, "agent");
            asm volatile("s_waitcnt vmcnt(0)" ::: "memory");
            const unsigned og = xb_add(&bar[XB_TOP], 1u);
            const unsigned tg = og / nx;
            if (og + 1u == (tg + 1u) * nx) xb_add(&bar[XB_TOPGEN], 1u);
            else XB_SPIN(xb_ld(&bar[XB_TOPGEN]) == tg, bar);
            __builtin_amdgcn_fence(__ATOMIC_ACQUIRE, "agent");
            xb_add(&bar[XB_XGEN(b.x)], 1u);
            asm volatile("s_waitcnt vmcnt(0)" ::: "memory");
        } else {
            XB_SPIN(xb_ld(&bar[XB_XGEN(b.x)]) == gen, bar);
            __builtin_amdgcn_fence(__ATOMIC_ACQUIRE, "agent");
            asm volatile("s_waitcnt vmcnt(0)" ::: "memory");
        }
    }
    __syncthreads();
}


struct Params { const float* in[33]; float* out; unsigned char* ws; int ph_lo, ph_hi; };
struct Frame { LAS unsigned char* lds; int tid, lane, wave, vcu, G; };

template <int CTRL, int RMASK> __device__ __forceinline__ float dpp_f(float x) {
    return __builtin_bit_cast(float, __builtin_amdgcn_update_dpp(0, __builtin_bit_cast(int, x), CTRL, RMASK, 0xf, false));
}
__device__ __forceinline__ float wsum(float x) {
    x += dpp_f<0xB1, 0xf>(x);
    x += dpp_f<0x4E, 0xf>(x);
    x += dpp_f<0x141, 0xf>(x);
    x += dpp_f<0x140, 0xf>(x);
    x += dpp_f<0x142, 0xa>(x);
    x += dpp_f<0x143, 0xc>(x);
    return __builtin_bit_cast(float, __builtin_amdgcn_readlane(__builtin_bit_cast(int, x), 63));
}
__device__ __forceinline__ int crow(int r, int hi) { return (r & 3) + 8 * (r >> 2) + 4 * hi; }
__device__ __forceinline__ float fsigmoid(float x) { return __builtin_amdgcn_rcpf(1.f + __builtin_amdgcn_exp2f(-1.4426950408889634f * x)); }
__device__ __forceinline__ float ftanh(float x) { return 2.f * fsigmoid(2.f * x) - 1.f; }

__device__ __forceinline__ void transpose_item(const float* W, int ldw, bf16_t* WT, int ldt, int k0, int n0, int drow0, LAS float* scr, int lane) {
#pragma unroll 8
    for (int i = 0; i < 32; ++i) { const int kk = 2 * i + (lane >> 5); scr[kk * 33 + (lane & 31)] = W[(size_t)(k0 + kk) * ldw + n0 + (lane & 31)]; }
    asm volatile("s_waitcnt lgkmcnt(0)" ::: "memory");
    const int c = lane & 7;
#pragma unroll
    for (int j = 0; j < 4; ++j) { const int n = (lane >> 3) + 8 * j; const LAS float* s = scr + (8 * c) * 33 + n;
        u32x4_t o; o.x = pk2(s[0 * 33], s[1 * 33]); o.y = pk2(s[2 * 33], s[3 * 33]); o.z = pk2(s[4 * 33], s[5 * 33]); o.w = pk2(s[6 * 33], s[7 * 33]);
        *(u32x4_t*)(WT + (size_t)(drow0 + n) * ldt + k0 + 8 * c) = o; }
    asm volatile("s_waitcnt lgkmcnt(0)" ::: "memory");
}
constexpr int IT_IN = 16 * 72, IT_OUT = 16 * 32, IT_QKV = 16 * 96, IT_DENSE = IT_IN + 2 * IT_OUT + IT_QKV;
constexpr int IT_GU = 16 * 16, IT_DN = 8 * 32, IT_EXP = 2 * IT_GU + IT_DN;
__device__ __forceinline__ void conv_dense_item(const Params& P, int it, LAS float* scr, int lane) {
    unsigned char* ws = P.ws;
    if (it < IT_IN) { const int kb = it / 72, nb = it % 72; transpose_item(P.in[4], INW, (bf16_t*)(ws + WS_WIN), D, kb * 64, nb * 32, nb * 32, scr, lane); return; } it -= IT_IN;
    if (it < IT_OUT) { const int kb = it / 32, nb = it % 32; transpose_item(P.in[18], D, (bf16_t*)(ws + WS_WOUT), D, kb * 64, nb * 32, nb * 32, scr, lane); return; } it -= IT_OUT;
    if (it < IT_QKV) { const int kb = it / 96, nb = it % 96; transpose_item(P.in[19], QKVW, (bf16_t*)(ws + WS_WQKV), D, kb * 64, nb * 32, nb * 32, scr, lane); return; } it -= IT_QKV;
    { const int kb = it / 32, nb = it % 32; transpose_item(P.in[25], D, (bf16_t*)(ws + WS_CWOUT), D, kb * 64, nb * 32, nb * 32, scr, lane); }
}
__device__ __forceinline__ void conv_moe_item(const Params& P, int it, LAS float* scr, int lane) {
    const int le = it / IT_EXP; int r = it % IT_EXP;
    if (r < 2 * IT_GU) {
        const int isup = r / IT_GU; r %= IT_GU; const int kb = r / 16, nb = r % 16, n0 = nb * 32;
        const float* W = (isup ? P.in[31] : P.in[30]) + (size_t)le * D * MH;
        transpose_item(W, MH, (bf16_t*)(P.ws + WS_W1T) + (size_t)le * 1024 * D, D, kb * 64, n0, (n0 / 128) * 256 + isup * 128 + (n0 % 128), scr, lane);
    } else {
        r -= 2 * IT_GU; const int kb = r / 32, nb = r % 32;
        transpose_item(P.in[32] + (size_t)le * MH * D, D, (bf16_t*)(P.ws + WS_W2T) + (size_t)le * D * MH, MH, kb * 64, nb * 32, nb * 32, scr, lane);
    }
}
__device__ __forceinline__ void rms_row_to_bf16(const float* xrow, const float* g, bf16_t* orow, int lane) {
    const f32x4_t* xr = (const f32x4_t*)xrow + lane; const f32x4_t* gr = (const f32x4_t*)g + lane;
    f32x4_t v[4]; float s = 0.f;
#pragma unroll
    for (int j = 0; j < 4; ++j) { v[j] = xr[64 * j]; s += (v[j].x * v[j].x + v[j].y * v[j].y) + (v[j].z * v[j].z + v[j].w * v[j].w); }
    const float rs = rsqrtf(wsum(s) * (1.f / D) + 1e-6f);
    u32x2_t* o8 = (u32x2_t*)orow + lane;
#pragma unroll
    for (int j = 0; j < 4; ++j) { const f32x4_t gg = gr[64 * j]; u32x2_t o; o.x = pk2(v[j].x * rs * gg.x, v[j].y * rs * gg.y); o.y = pk2(v[j].z * rs * gg.z, v[j].w * rs * gg.w); o8[64 * j] = o; }
}

__device__ __forceinline__ void ph_prologue(const Frame& F, const Params& P) {
    LAS float* scr = (LAS float*)(F.lds + F.wave * 16384);
    const int gw = F.vcu * 8 + F.wave, NGW = F.G * 8;
    for (int it = gw; it < IT_DENSE; it += NGW) conv_dense_item(P, it, scr, F.lane);
    for (int it = gw; it < 64 * IT_EXP; it += NGW) conv_moe_item(P, it, scr, F.lane);
    bf16_t* w2p = (bf16_t*)(P.ws + WS_SMALLW); bf16_t* a2p = w2p + 32768; bf16_t* g2p = a2p + 32768; bf16_t* wpp = g2p + 65536; float* cs = (float*)(wpp + 65536);
    const int gt = F.vcu * 512 + F.tid, NGT = F.G * 512;
    for (int idx = gt; idx < 32768; idx += NGT) {
        const int row = idx >> 6, k = idx & 63, hd = row >> 6, nt = (row >> 5) & 1, c = row & 31, col = hd * 64 + 2 * c + nt;
        w2p[idx] = (bf16_t)f2bf(P.in[7][k * RW + col]); a2p[idx] = (bf16_t)f2bf(P.in[9][k * RW + col]);
    }
    for (int idx = gt; idx < 65536; idx += NGT) {
        { const int row = idx >> 7, k = idx & 127, hd = row >> 6, nt = (row >> 5) & 1, c = row & 31, col = hd * 64 + 2 * c + nt; g2p[idx] = (bf16_t)f2bf(P.in[10][k * RW + col]); }
        { const int gi = idx >> 14, row = (idx >> 7) & 127, k = idx & 127, nh = row >> 6, nt = (row >> 5) & 1, c = row & 31, n = nh * 64 + 2 * c + nt;
          wpp[idx] = (bf16_t)f2bf(P.in[16][(size_t)gi * 16384 + k * 128 + n]); }
    }
    for (int i = gt; i < SEQ * 8; i += NGT) {
        const int t = i >> 3, f = i & 7;
        const double inv = exp(-log(500000.0) * (double)f / 8.0), ang = (double)t * inv;
        cs[i * 2] = (float)cos(ang); cs[i * 2 + 1] = (float)sin(ang);
    }
    for (int m = gw; m < NTOK; m += NGW) rms_row_to_bf16(P.in[0] + (size_t)m * D, P.in[1], (bf16_t*)(P.ws + WS_XN) + (size_t)m * D, F.lane);
}

__device__ __forceinline__ void ph_prep(const Frame& F, const Params& P) {
    const bf16_t* p = (const bf16_t*)(P.ws + WS_BIG);
    const float* mu = P.in[5]; const float* w0 = P.in[6]; const float* a0 = P.in[8]; const float* k_k = P.in[11]; const float* k_a = P.in[12]; const float* pool_scale = P.in[17];
    const bf16_t* w2p = (const bf16_t*)(P.ws + WS_SMALLW); const bf16_t* a2p = w2p + 32768; const bf16_t* g2p = a2p + 32768; const bf16_t* wpp = g2p + 65536;
    float* Wd = (float*)(P.ws + WS_R3);
    bf16_t* Rb = (bf16_t*)(P.ws + WS_R3 + 32 * MiB); bf16_t* Kb = Rb + (size_t)NTOK * RW; bf16_t* KKb = Kb + (size_t)NTOK * RW; bf16_t* Bb = KKb + (size_t)NTOK * RW; bf16_t* Vb = Bb + (size_t)NTOK * RW;
    bf16_t* Gb = (bf16_t*)(P.ws + WS_G); bf16_t* XN = (bf16_t*)(P.ws + WS_XN);
    LAS unsigned char* lora = F.lds; LAS unsigned char* poold = F.lds + 32 * 528;
    const int tid = F.tid, lane = F.lane, r32 = lane & 31, hi = lane >> 5, hd = F.wave;
    for (int unit = F.vcu; unit < NTOK / 32; unit += F.G) {
        const int tok0 = unit * 32, t0 = tok0 % SEQ;
        {
            const int tl = tid >> 4, c0 = (tid & 15) * 16, t = t0 + tl;
            const bf16_t* pc = p + (size_t)(tok0 + tl) * INW + 1536 + c0;
            u32x4_t cu[2], pv[2];
            cu[0] = *(const u32x4_t*)pc; cu[1] = *(const u32x4_t*)(pc + 8);
            if (t > 0) { pv[0] = *(const u32x4_t*)(pc - INW); pv[1] = *(const u32x4_t*)(pc - INW + 8); } else { pv[0] = (u32x4_t){0, 0, 0, 0}; pv[1] = pv[0]; }
            u32x4_t ov[2];
#pragma unroll
            for (int h2 = 0; h2 < 2; ++h2) {
#pragma unroll
                for (int q = 0; q < 4; ++q) {
                    const f32x2_t m2 = *(const f32x2_t*)(mu + 1536 + c0 + h2 * 8 + q * 2);
                    const float c_lo = bflo(cu[h2][q]), c_hi = bfhi(cu[h2][q]), p_lo = bflo(pv[h2][q]), p_hi = bfhi(pv[h2][q]);
                    float z0 = c_lo + (p_lo - c_lo) * m2.x, z1 = c_hi + (p_hi - c_hi) * m2.y;
                    if (c0 < 64) { z0 = ftanh(z0); z1 = ftanh(z1); } else if (c0 >= 128) { z0 = fsigmoid(z0); z1 = fsigmoid(z1); }
                    ov[h2][q] = pk2(z0, z1);
                }
            }
            *(LAS u32x4_t*)(lora + tl * 528 + c0 * 2) = ov[0]; *(LAS u32x4_t*)(lora + tl * 528 + c0 * 2 + 16) = ov[1];
        }
        {
            const int c = tid, gi = c >> 7, win = 2 << gi;
            const bf16_t* pu = p + (size_t)tok0 * INW + SHIFTW + c;
            float s = 0.f;
            for (int q = 1; q < win; ++q) if (t0 - q >= 0) s += bf2f(pu[-(ptrdiff_t)q * INW]);
            for (int tl = 0; tl < 32; ++tl) {
                const int t = t0 + tl; const float u = bf2f(pu[(ptrdiff_t)tl * INW]);
                s += u;
                const int cnt = (t + 1 < win) ? (t + 1) : win;
                *(LAS bf16_t*)(poold + tl * 1040 + c * 2) = (bf16_t)f2bf(s / (float)cnt - u);
                if (t - win + 1 >= 0) s -= bf2f(pu[(ptrdiff_t)(tl - win + 1) * INW]);
            }
        }
        __syncthreads();
        const int ch = hd * 64 + 2 * r32;
        const LAS unsigned char* arow = lora + r32 * 528 + hi * 16;
        {
            f32x16_t acc0 = {}, acc1 = {};
#pragma unroll
            for (int ks = 0; ks < 8; ++ks) {
                const bf16x8_t a = *(const LAS bf16x8_t*)(arow + (128 + ks * 16) * 2);
                const bf16x8_t b0 = *(const bf16x8_t*)(g2p + (size_t)(hd * 64 + r32) * 128 + ks * 16 + hi * 8);
                const bf16x8_t b1 = *(const bf16x8_t*)(g2p + (size_t)(hd * 64 + 32 + r32) * 128 + ks * 16 + hi * 8);
                acc0 = __builtin_amdgcn_mfma_f32_32x32x16_bf16(a, b0, acc0, 0, 0, 0); acc1 = __builtin_amdgcn_mfma_f32_32x32x16_bf16(a, b1, acc1, 0, 0, 0);
            }
#pragma unroll
            for (int r = 0; r < 16; ++r) *(unsigned*)(Gb + (size_t)(tok0 + crow(r, hi)) * RW + ch) = pk2(acc0[r], acc1[r]);
        }
        {
            f32x16_t acc0 = {}, acc1 = {};
#pragma unroll
            for (int ks = 0; ks < 4; ++ks) {
                const bf16x8_t a = *(const LAS bf16x8_t*)(arow + (ks * 16) * 2);
                const bf16x8_t b0 = *(const bf16x8_t*)(w2p + (size_t)(hd * 64 + r32) * 64 + ks * 16 + hi * 8);
                const bf16x8_t b1 = *(const bf16x8_t*)(w2p + (size_t)(hd * 64 + 32 + r32) * 64 + ks * 16 + hi * 8);
                acc0 = __builtin_amdgcn_mfma_f32_32x32x16_bf16(a, b0, acc0, 0, 0, 0); acc1 = __builtin_amdgcn_mfma_f32_32x32x16_bf16(a, b1, acc1, 0, 0, 0);
            }
            const f32x2_t w0p = *(const f32x2_t*)(w0 + ch);
#pragma unroll
            for (int r = 0; r < 16; ++r) {
                f32x2_t dv;
                dv.x = __builtin_amdgcn_exp2f(-1.4426950408889634f * 0.6065306597126334f * fsigmoid(w0p.x + acc0[r]));
                dv.y = __builtin_amdgcn_exp2f(-1.4426950408889634f * 0.6065306597126334f * fsigmoid(w0p.y + acc1[r]));
                *(f32x2_t*)(Wd + (size_t)(tok0 + crow(r, hi)) * RW + ch) = dv;
            }
        }
        {
            f32x16_t acc0 = {}, acc1 = {};
#pragma unroll
            for (int ks = 0; ks < 4; ++ks) {
                const bf16x8_t a = *(const LAS bf16x8_t*)(arow + (64 + ks * 16) * 2);
                const bf16x8_t b0 = *(const bf16x8_t*)(a2p + (size_t)(hd * 64 + r32) * 64 + ks * 16 + hi * 8);
                const bf16x8_t b1 = *(const bf16x8_t*)(a2p + (size_t)(hd * 64 + 32 + r32) * 64 + ks * 16 + hi * 8);
                acc0 = __builtin_amdgcn_mfma_f32_32x32x16_bf16(a, b0, acc0, 0, 0, 0); acc1 = __builtin_amdgcn_mfma_f32_32x32x16_bf16(a, b1, acc1, 0, 0, 0);
            }
            const f32x2_t a0p = *(const f32x2_t*)(a0 + ch), kkp = *(const f32x2_t*)(k_k + ch), kap = *(const f32x2_t*)(k_a + ch);
            const f32x2_t mur = *(const f32x2_t*)(mu + ch), muk = *(const f32x2_t*)(mu + 512 + ch), muv = *(const f32x2_t*)(mu + 1024 + ch);
#pragma unroll
            for (int r = 0; r < 16; ++r) {
                const int row = crow(r, hi), t = t0 + row; const size_t tok = (size_t)(tok0 + row);
                const bf16_t* pc = p + tok * INW + ch;
                const unsigned cr = *(const unsigned*)pc, ck = *(const unsigned*)(pc + 512), cv = *(const unsigned*)(pc + 1024);
                unsigned qr = 0, qk = 0, qv = 0;
                if (t > 0) { qr = *(const unsigned*)(pc - INW); qk = *(const unsigned*)(pc - INW + 512); qv = *(const unsigned*)(pc - INW + 1024); }
                const float r0 = bflo(cr) + (bflo(qr) - bflo(cr)) * mur.x, r1 = bfhi(cr) + (bfhi(qr) - bfhi(cr)) * mur.y;
                const float k0 = bflo(ck) + (bflo(qk) - bflo(ck)) * muk.x, k1 = bfhi(ck) + (bfhi(qk) - bfhi(ck)) * muk.y;
                const float v0 = bflo(cv) + (bflo(qv) - bflo(cv)) * muv.x, v1 = bfhi(cv) + (bfhi(qv) - bfhi(cv)) * muv.y;
                const float av0 = fsigmoid(a0p.x + acc0[r]), av1 = fsigmoid(a0p.y + acc1[r]);
                float kk0 = k0 * kkp.x, kk1 = k1 * kkp.y;
                float ss = kk0 * kk0 + kk1 * kk1;
#pragma unroll
                for (int o = 1; o < 32; o <<= 1) ss += __shfl_xor(ss, o);
                const float inv = 1.f / fmaxf(sqrtf(ss), 1e-12f);
                kk0 *= inv; kk1 *= inv;
                const size_t o = tok * RW + ch;
                *(unsigned*)(Rb + o) = pk2(r0, r1);
                *(unsigned*)(Kb + o) = pk2(k0 * (1.f + (av0 - 1.f) * kap.x), k1 * (1.f + (av1 - 1.f) * kap.y));
                *(unsigned*)(Vb + o) = pk2(v0, v1);
                *(unsigned*)(KKb + o) = pk2(kk0, kk1);
                *(unsigned*)(Bb + o) = pk2(kk0 * av0, kk1 * av1);
            }
        }
        {
            const int gi = F.wave >> 1, nh = F.wave & 1;
            const LAS unsigned char* prow = poold + r32 * 1040 + (gi * 128 + hi * 8) * 2;
            f32x16_t acc0 = {}, acc1 = {};
#pragma unroll
            for (int ks = 0; ks < 8; ++ks) {
                const bf16x8_t a = *(const LAS bf16x8_t*)(prow + ks * 32);
                const bf16x8_t b0 = *(const bf16x8_t*)(wpp + (size_t)(gi * 128 + nh * 64 + r32) * 128 + ks * 16 + hi * 8);
                const bf16x8_t b1 = *(const bf16x8_t*)(wpp + (size_t)(gi * 128 + nh * 64 + 32 + r32) * 128 + ks * 16 + hi * 8);
                acc0 = __builtin_amdgcn_mfma_f32_32x32x16_bf16(a, b0, acc0, 0, 0, 0); acc1 = __builtin_amdgcn_mfma_f32_32x32x16_bf16(a, b1, acc1, 0, 0, 0);
            }
            const int n = gi * 128 + nh * 64 + 2 * r32;
            const f32x2_t ps = *(const f32x2_t*)(pool_scale + n);
#pragma unroll
            for (int r = 0; r < 16; ++r) *(unsigned*)(XN + (size_t)(tok0 + crow(r, hi)) * D + RW + n) = pk2(acc0[r] * ps.x, acc1[r] * ps.y);
        }
        __syncthreads();
    }
}

constexpr int TC = 32, TCP = 36, SC_ARR = 64 * TCP * 4, SC_BUF = 6 * SC_ARR;
__device__ __forceinline__ void ph_scan(const Frame& F, const Params& P) {
    const float* Wd = (const float*)(P.ws + WS_R3);
    const bf16_t* Rb = (const bf16_t*)(P.ws + WS_R3 + 32 * MiB); const bf16_t* Kb = Rb + (size_t)NTOK * RW; const bf16_t* KKb = Kb + (size_t)NTOK * RW; const bf16_t* Bb = KKb + (size_t)NTOK * RW; const bf16_t* Vb = Bb + (size_t)NTOK * RW;
    float* Y = (float*)(P.ws + WS_Y);
    const int tid = F.tid, lane = F.lane, wave = F.wave;
    LAS float* ybuf = (LAS float*)(F.lds + 2 * SC_BUF);
    for (int unit = F.vcu; unit < 256; unit += F.G) {
        const int bh = unit >> 3, rg = unit & 7, bb = bh >> 3, hd = bh & 7, irow = rg * 8 + wave;
        const size_t base = (size_t)bb * SEQ * RW + hd * 64;
        f32x4_t nW; u32x4_t nB[3];
#define SCAN_ISSUE(c_) do { const size_t tb = base + (size_t)((c_) * TC) * RW; \
            nW = *(const f32x4_t*)(Wd + tb + (size_t)(tid >> 4) * RW + (tid & 15) * 4); \
            _Pragma("unroll") for (int m = 0; m < 3; ++m) { const int q = tid + 512 * m; if (q < 1280) { const int arr = q >> 8, w = q & 255; \
                const bf16_t* src = (arr == 0 ? Kb : arr == 1 ? KKb : arr == 2 ? Bb : arr == 3 ? Rb : Vb) + tb + (size_t)(w >> 3) * RW + (w & 7) * 8; \
                nB[m] = *(const u32x4_t*)src; } } } while (0)
#define SCAN_COMMIT(buf_) do { LAS float* L_ = (LAS float*)(F.lds + (buf_) * SC_BUF); \
            { const int tt = tid >> 4, j0 = (tid & 15) * 4; \
              _Pragma("unroll") for (int q = 0; q < 4; ++q) L_[(j0 + q) * TCP + tt] = nW[q]; } \
            _Pragma("unroll") for (int m = 0; m < 3; ++m) { const int q = tid + 512 * m; if (q < 1280) { const int arr = q >> 8, w = q & 255, tt = w >> 3, j0 = (w & 7) * 8; \
                LAS float* A_ = L_ + (1 + arr) * (64 * TCP); \
                _Pragma("unroll") for (int e = 0; e < 4; ++e) { A_[(j0 + 2 * e) * TCP + tt] = bflo(nB[m][e]); A_[(j0 + 2 * e + 1) * TCP + tt] = bfhi(nB[m][e]); } } } } while (0)
        SCAN_ISSUE(0); SCAN_COMMIT(0);
        __syncthreads();
        float S = 0.f;
        for (int c = 0; c < SEQ / TC; ++c) {
            if (c + 1 < SEQ / TC) SCAN_ISSUE(c + 1);
            if (c > 0 && tid < 256) {
                const int tt = tid >> 3, r = tid & 7;
                Y[base + (size_t)((c - 1) * TC + tt) * RW + rg * 8 + r] = ybuf[((c - 1) & 1) * 256 + tt * 8 + r];
            }
            const LAS float* L = (const LAS float*)(F.lds + (c & 1) * SC_BUF);
            const LAS float* lw = L + lane * TCP; const LAS float* lk = lw + 64 * TCP; const LAS float* lkk = lk + 64 * TCP; const LAS float* lb = lkk + 64 * TCP; const LAS float* lr = lb + 64 * TCP;
            const LAS float* lv = L + 5 * 64 * TCP + irow * TCP;
            float yacc = 0.f;
#pragma unroll
            for (int t4 = 0; t4 < TC / 4; ++t4) {
                const f32x4_t w4 = *(const LAS f32x4_t*)(lw + t4 * 4), k4 = *(const LAS f32x4_t*)(lk + t4 * 4), kk4 = *(const LAS f32x4_t*)(lkk + t4 * 4);
                const f32x4_t b4 = *(const LAS f32x4_t*)(lb + t4 * 4), r4 = *(const LAS f32x4_t*)(lr + t4 * 4), v4 = *(const LAS f32x4_t*)(lv + t4 * 4);
#pragma unroll
                for (int q = 0; q < 4; ++q) {
                    const float sa = wsum(S * kk4[q]);
                    S = fmaf(S, w4[q], fmaf(-sa, b4[q], v4[q] * k4[q]));
                    const float yv = wsum(S * r4[q]);
                    yacc = (lane == t4 * 4 + q) ? yv : yacc;
                }
            }
            if (lane < 32) ybuf[(c & 1) * 256 + lane * 8 + wave] = yacc;
            if (c + 1 < SEQ / TC) SCAN_COMMIT((c + 1) & 1);
            __syncthreads();
        }
        if (tid < 256) { const int tt = tid >> 3, r = tid & 7, c = SEQ / TC - 1;
            Y[base + (size_t)(c * TC + tt) * RW + rg * 8 + r] = ybuf[(c & 1) * 256 + tt * 8 + r]; }
        __syncthreads();
    }
}

__device__ __forceinline__ void ph_post(const Frame& F, const Params& P) {
    const float* Y = (const float*)(P.ws + WS_Y);
    const bf16_t* Rb = (const bf16_t*)(P.ws + WS_R3 + 32 * MiB); const bf16_t* Kb = Rb + (size_t)NTOK * RW; const bf16_t* Vb = Rb + (size_t)NTOK * RW * 4;
    const bf16_t* Gb = (const bf16_t*)(P.ws + WS_G); bf16_t* XN = (bf16_t*)(P.ws + WS_XN);
    const float* ln_w = P.in[14]; const float* ln_b = P.in[15]; const float* r_k = P.in[13];
    const int gw = F.vcu * 8 + F.wave, NGW = F.G * 8, lane = F.lane;
    for (int tok = gw; tok < NTOK; tok += NGW) {
#pragma unroll
        for (int hd = 0; hd < 8; ++hd) {
            const int ch = hd * 64 + lane; const size_t o = (size_t)tok * RW + ch;
            const float yv = Y[o];
            const float mean = wsum(yv) * (1.f / 64.f);
            const float d = yv - mean;
            const float var = wsum(d * d) * (1.f / 64.f);
            float yn = d * rsqrtf(var + 64e-5f) * ln_w[ch] + ln_b[ch];
            const float bonus = wsum(bf2f(Rb[o]) * bf2f(Kb[o]) * r_k[ch]);
            yn += bonus * bf2f(Vb[o]);
            XN[(size_t)tok * D + ch] = (bf16_t)f2bf(yn * bf2f(Gb[o]));
        }
    }
}

__device__ __forceinline__ void ph_router(const Frame& F, const Params& P, int layer) {
    const float* x = P.out; const float* gnorm = P.in[2] + layer * D;
    const float* w_group = P.in[26] + (size_t)layer * D * 4; const float* b_group = P.in[27] + layer * 4;
    const float* w_expert = P.in[28] + (size_t)layer * D * 32; const float* b_expert = P.in[29] + layer * 32;
    bf16_t* XN = (bf16_t*)(P.ws + WS_XN);
    int* eid = (int*)(P.ws + WS_MISC); int* posn = eid + NASSIGN; float* wts = (float*)(posn + NASSIGN);
    unsigned* counts = (unsigned*)(P.ws + WS_CTL) + (layer ? CW_MOE1 : CW_MOE0);
    LAS float* Wl = (LAS float*)F.lds;
    for (int idx = F.tid; idx < 1024 * 36; idx += 512) { const int k = idx / 36, j = idx - k * 36; Wl[idx] = (j < 4) ? w_group[k * 4 + j] : w_expert[k * 32 + j - 4]; }
    __syncthreads();
    const int gw = F.vcu * 8 + F.wave, NGW = F.G * 8, lane = F.lane;
    for (int tok = gw; tok < NTOK; tok += NGW) {
        const float* xr = x + (size_t)tok * D + lane;
        float ss = 0.f;
#pragma unroll
        for (int m = 0; m < 16; ++m) { const float xv = xr[64 * m]; ss += xv * xv; }
        const float rs = rsqrtf(wsum(ss) * (1.f / D) + 1e-6f);
        float acc[36];
#pragma unroll
        for (int j = 0; j < 36; ++j) acc[j] = 0.f;
#pragma unroll 2
        for (int m = 0; m < 16; ++m) {
            const float hm = xr[64 * m] * rs * gnorm[lane + 64 * m];
            XN[(size_t)tok * D + lane + 64 * m] = (bf16_t)f2bf(hm);
            const LAS f32x4_t* wr = (const LAS f32x4_t*)(Wl + (lane + 64 * m) * 36);
#pragma unroll
            for (int q = 0; q < 9; ++q) { const f32x4_t w4 = wr[q]; acc[4 * q] += hm * w4.x; acc[4 * q + 1] += hm * w4.y; acc[4 * q + 2] += hm * w4.z; acc[4 * q + 3] += hm * w4.w; }
        }
        float lg[36];
#pragma unroll
        for (int j = 0; j < 36; ++j) lg[j] = wsum(acc[j]) + ((j < 4) ? b_group[j] : b_expert[j - 4]);
        int gi = 0; float gm = lg[0];
#pragma unroll
        for (int j = 1; j < 4; ++j) if (lg[j] > gm) { gm = lg[j]; gi = j; }
        float den = 0.f;
#pragma unroll
        for (int j = 0; j < 4; ++j) den += expf(lg[j] - gm);
        const float gwt = 1.f / den;
        float el[8];
#pragma unroll
        for (int j = 0; j < 8; ++j) el[j] = (gi == 0) ? lg[4 + j] : (gi == 1) ? lg[12 + j] : (gi == 2) ? lg[20 + j] : lg[28 + j];
        int i0 = 0; float v0 = el[0];
#pragma unroll
        for (int j = 1; j < 8; ++j) if (el[j] > v0) { v0 = el[j]; i0 = j; }
        int i1 = 0; float v1 = -INFINITY;
#pragma unroll
        for (int j = 0; j < 8; ++j) if (j != i0 && el[j] > v1) { v1 = el[j]; i1 = j; }
        const float e1 = expf(v1 - v0);
        const float p0 = 1.f / (1.f + e1), p1 = e1 / (1.f + e1);
        if (lane < 2) {
            const int e = gi * 8 + (lane ? i1 : i0);
            const unsigned pos = __hip_atomic_fetch_add(counts + 64 * e, 1u, __ATOMIC_RELAXED, __HIP_MEMORY_SCOPE_AGENT);
            eid[tok * 2 + lane] = e; posn[tok * 2 + lane] = (int)pos; wts[tok * 2 + lane] = (lane ? p1 : p0) * gwt;
        }
    }
    __syncthreads();
}

__device__ __forceinline__ void ph_gather(const Frame& F, const Params& P, int layer) {
    unsigned* ctl = (unsigned*)(P.ws + WS_CTL) + (layer ? CW_MOE1 : CW_MOE0);
    const bf16_t* XN = (const bf16_t*)(P.ws + WS_XN); bf16_t* Xg = (bf16_t*)(P.ws + WS_R3);
    const int* eid = (const int*)(P.ws + WS_MISC); const int* posn = eid + NASSIGN; const float* wts = (const float*)(posn + NASSIGN);
    int* tok_slot = (int*)(wts + NASSIGN); float* slot_wt = (float*)(tok_slot + NASSIGN);
    LAS int* pstart = (LAS int*)F.lds;
    if (F.tid == 0) {
        int start = 0;
        for (int e = 0; e < NEXP; ++e) {
            const int c = (int)__hip_atomic_load(ctl + 64 * e, __ATOMIC_RELAXED, __HIP_MEMORY_SCOPE_AGENT);
            const int nb = (c + MBLK - 1) / MBLK;
            pstart[e] = start;
            if (blockIdx.x == 0) for (int q = 0; q < nb; ++q) ctl[MOE_PLAN + 128 + start / MBLK + q] = (unsigned)e;
            start += nb * MBLK;
        }
        if (blockIdx.x == 0) ctl[MOE_PLAN + 96] = (unsigned)(start / MBLK);
    }
    __syncthreads();
    const int gw = F.vcu * 8 + F.wave, NGW = F.G * 8, lane = F.lane;
    for (int a = gw; a < NASSIGN; a += NGW) {
        const int slot = pstart[eid[a]] + posn[a];
        const u32x4_t* src = (const u32x4_t*)(XN + (size_t)(a >> 1) * D);
        u32x4_t* dst = (u32x4_t*)(Xg + (size_t)slot * D);
        dst[lane] = src[lane]; dst[64 + lane] = src[64 + lane];
        if (lane == 0) { tok_slot[a] = slot; slot_wt[slot] = wts[a]; }
    }
    __syncthreads();
}

template <bool FINAL> __device__ __forceinline__ void ph_combine(const Frame& F, const Params& P, const float* gnorm) {
    float* x = P.out; const bf16_t* Yb = (const bf16_t*)(P.ws + WS_BIG); bf16_t* XN = (bf16_t*)(P.ws + WS_XN);
    const int* tok_slot = (const int*)(P.ws + WS_MISC) + 3 * NASSIGN;
    const int gw = F.vcu * 8 + F.wave, NGW = F.G * 8, lane = F.lane;
    for (int tok = gw; tok < NTOK; tok += NGW) {
        const int s0 = tok_slot[tok * 2], s1 = tok_slot[tok * 2 + 1];
        f32x4_t* xr = (f32x4_t*)(x + (size_t)tok * D) + lane;
        const u32x2_t* y0 = (const u32x2_t*)(Yb + (size_t)s0 * D) + lane; const u32x2_t* y1 = (const u32x2_t*)(Yb + (size_t)s1 * D) + lane;
        f32x4_t v[4]; float ss = 0.f;
#pragma unroll
        for (int j = 0; j < 4; ++j) {
            v[j] = xr[64 * j]; const u32x2_t a = y0[64 * j], b = y1[64 * j];
            v[j].x += bflo(a.x) + bflo(b.x); v[j].y += bfhi(a.x) + bfhi(b.x); v[j].z += bflo(a.y) + bflo(b.y); v[j].w += bfhi(a.y) + bfhi(b.y);
            ss += (v[j].x * v[j].x + v[j].y * v[j].y) + (v[j].z * v[j].z + v[j].w * v[j].w);
        }
        const float rs = rsqrtf(wsum(ss) * (1.f / D) + 1e-6f);
        const f32x4_t* gr = (const f32x4_t*)gnorm + lane;
#pragma unroll
        for (int j = 0; j < 4; ++j) {
            const f32x4_t gg = gr[64 * j];
            if (FINAL) { f32x4_t o; o.x = v[j].x * rs * gg.x; o.y = v[j].y * rs * gg.y; o.z = v[j].z * rs * gg.z; o.w = v[j].w * rs * gg.w; xr[64 * j] = o; }
            else { xr[64 * j] = v[j]; u32x2_t o; o.x = pk2(v[j].x * rs * gg.x, v[j].y * rs * gg.y); o.y = pk2(v[j].z * rs * gg.z, v[j].w * rs * gg.w); ((u32x2_t*)(XN + (size_t)tok * D) + lane)[64 * j] = o; }
        }
    }
}

__device__ __forceinline__ void ph_attn_combine(const Frame& F, const Params& P) {
    const bf16_t* O = (const bf16_t*)(P.ws + WS_R3); bf16_t* XN = (bf16_t*)(P.ws + WS_XN);
    const float lambda_init = 0.35550906f;
    const int gw = F.vcu * 8 + F.wave, NGW = F.G * 8, lane = F.lane;
    const float la = wsum(P.in[20][lane] * P.in[21][lane]), lb = wsum(P.in[22][lane] * P.in[23][lane]);
    const float lam = expf(la) - expf(lb) + lambda_init;
    const float s0 = P.in[24][lane] * (1.f - lambda_init), s1 = P.in[24][64 + lane] * (1.f - lambda_init);
    for (int tok = gw; tok < NTOK; tok += NGW) {
        const bf16_t* Or = O + (size_t)tok * 2048;
#pragma unroll
        for (int h = 0; h < 8; ++h) {
            const float oa = bf2f(Or[(h * 4 + 0) * 64 + lane]) - lam * bf2f(Or[(h * 4 + 2) * 64 + lane]);
            const float ob = bf2f(Or[(h * 4 + 1) * 64 + lane]) - lam * bf2f(Or[(h * 4 + 3) * 64 + lane]);
            const float rs = rsqrtf(wsum(oa * oa + ob * ob) * (1.f / 128.f) + 1e-5f);
            XN[(size_t)tok * D + h * 128 + lane] = (bf16_t)f2bf(oa * rs * s0);
            XN[(size_t)tok * D + h * 128 + 64 + lane] = (bf16_t)f2bf(ob * rs * s1);
        }
    }
}

constexpr int N_PHASES = 20;
__device__ __forceinline__ Frame make_frame(unsigned char* lds_raw) {
    Frame F; F.lds = (LAS unsigned char*)lds_raw;
    F.tid = threadIdx.x; F.lane = F.tid & 63; F.wave = __builtin_amdgcn_readfirstlane(F.tid >> 6);
    F.G = gridDim.x; { const int bx = blockIdx.x; F.vcu = (F.G % 8 == 0) ? (bx % 8) * (F.G / 8) + bx / 8 : bx; }
    return F;
}
constexpr int PTBL_OFF = MISC_OFF + 256;
__device__ __forceinline__ Params load_params(unsigned char* lds_raw) {
    asm volatile("" ::: "memory");
    const LAS unsigned* t = (const LAS unsigned*)((LAS unsigned char*)lds_raw + PTBL_OFF);
    Params P;
#pragma unroll
    for (int i = 0; i < 33; ++i) { const unsigned lo = __builtin_amdgcn_readfirstlane(t[2 * i]), hi = __builtin_amdgcn_readfirstlane(t[2 * i + 1]); P.in[i] = (const float*)(const __attribute__((address_space(1))) float*)(((unsigned long long)hi << 32) | lo); }
    { const unsigned lo = __builtin_amdgcn_readfirstlane(t[66]), hi = __builtin_amdgcn_readfirstlane(t[67]); P.out = (float*)(__attribute__((address_space(1))) float*)(((unsigned long long)hi << 32) | lo); }
    { const unsigned lo = __builtin_amdgcn_readfirstlane(t[68]), hi = __builtin_amdgcn_readfirstlane(t[69]); P.ws = (unsigned char*)(__attribute__((address_space(1))) unsigned char*)(((unsigned long long)hi << 32) | lo); }
    P.ph_lo = (int)__builtin_amdgcn_readfirstlane(t[70]); P.ph_hi = (int)__builtin_amdgcn_readfirstlane(t[71]);
    return P;
}
__global__ void __launch_bounds__(512, 2) mega(Params Parg) {
    extern __shared__ __attribute__((aligned(16))) unsigned char lds_raw[];
    {
        volatile LAS unsigned* MISC = (volatile LAS unsigned*)((LAS unsigned char*)lds_raw + MISC_OFF);
        if (threadIdx.x < 32) MISC[threadIdx.x] = 0u;
        const unsigned* ka = (const unsigned*)__builtin_amdgcn_kernarg_segment_ptr();
        if (threadIdx.x < 72) ((LAS unsigned*)((LAS unsigned char*)lds_raw + PTBL_OFF))[threadIdx.x] = ka[threadIdx.x];
        __syncthreads();
    }
    const int ph_lo = load_params(lds_raw).ph_lo, ph_hi = load_params(lds_raw).ph_hi;
    if (ph_hi - ph_lo > 1) { (void)xcd_barrier_post((unsigned*)(load_params(lds_raw).ws + WS_CTL) + CW_BAR, (volatile LAS unsigned*)((LAS unsigned char*)lds_raw + MISC_OFF) + 8); }
#define IN(k) (ph_lo <= (k) && (k) < ph_hi)
#define SEAM(k) do { if (IN(k) && IN((k) + 1)) { XcdBarrier bar_; bar_.bar = (unsigned*)(load_params(lds_raw).ws + WS_CTL) + CW_BAR; bar_.x = xb_xcc_id(); \
        bar_.st = (volatile LAS unsigned*)((LAS unsigned char*)lds_raw + MISC_OFF) + 8; xcd_barrier(bar_); } } while (0)
#define WSB(off) ((bf16_t*)(P.ws + (off)))
    if (IN(0)) { const Params P = load_params(lds_raw); const Frame F = make_frame(lds_raw); ph_prologue(F, P); }
    SEAM(0);
    if (IN(1)) { const Params P = load_params(lds_raw); pg8::Gemm g{WSB(WS_XN), WSB(WS_WIN), NTOK, INW, D, 0}; pg8::EpiBf16Plain E{WSB(WS_BIG), INW, 0}; pg8::PlainOrder S{}; S.init(NTOK, INW, (int)gridDim.x, (int)blockIdx.x);
        pg8::gemm_phase<pg8::EpiBf16Plain, pg8::PlainOrder, true, true>((LAS unsigned char*)lds_raw, g, S, E); }
    SEAM(1);
    if (IN(2)) { const Params P = load_params(lds_raw); const Frame F = make_frame(lds_raw); ph_prep(F, P); }
    SEAM(2);
    if (IN(3)) { const Params P = load_params(lds_raw); const Frame F = make_frame(lds_raw); ph_scan(F, P); }
    SEAM(3);
    if (IN(4)) { const Params P = load_params(lds_raw); const Frame F = make_frame(lds_raw); ph_post(F, P); }
    SEAM(4);
    if (IN(5)) { const Params P = load_params(lds_raw); pg8::Gemm g{WSB(WS_XN), WSB(WS_WOUT), NTOK, D, D, 0}; pg8::EpiResF32 E{P.in[0], P.out, D, 0}; pg8::PlainOrder S{}; S.init(NTOK, D, (int)gridDim.x, (int)blockIdx.x);
        pg8::gemm_phase<pg8::EpiResF32, pg8::PlainOrder, true, true>((LAS unsigned char*)lds_raw, g, S, E); }
    SEAM(5);
#define MOE_PHASES(layer, pb) \
    if (IN(pb)) { const Params P = load_params(lds_raw); const Frame F = make_frame(lds_raw); ph_router(F, P, layer); } \
    SEAM(pb); \
    if (IN((pb) + 1)) { const Params P = load_params(lds_raw); const Frame F = make_frame(lds_raw); ph_gather(F, P, layer); } \
    SEAM((pb) + 1); \
    if (IN((pb) + 2)) { const Params P = load_params(lds_raw); const int* lctl = (const int*)(P.ws + WS_CTL) + ((layer) ? CW_MOE1 : CW_MOE0) + MOE_PLAN; \
        pg8::Gemm g{WSB(WS_R3), WSB(WS_W1T) + (size_t)(layer) * NEXP * 1024 * D, PMAX, 1024, D, 0}; pg8::EpiSwiglu E{WSB(WS_R3) + (size_t)40 * MiB}; \
        pg8::GroupedOrder S{lctl, (size_t)1024 * D * 2, 4, 0, 0, 0}; S.bind((int)gridDim.x, (int)blockIdx.x); \
        pg8::gemm_phase<pg8::EpiSwiglu, pg8::GroupedOrder, true, true>((LAS unsigned char*)lds_raw, g, S, E); } \
    SEAM((pb) + 2); \
    if (IN((pb) + 3)) { const Params P = load_params(lds_raw); const int* lctl = (const int*)(P.ws + WS_CTL) + ((layer) ? CW_MOE1 : CW_MOE0) + MOE_PLAN; \
        pg8::Gemm g{WSB(WS_R3) + (size_t)40 * MiB, WSB(WS_W2T) + (size_t)(layer) * NEXP * D * MH, PMAX, D, MH, 0}; \
        pg8::EpiScaleBf16 E{WSB(WS_BIG), (const float*)(P.ws + WS_MISC) + 4 * NASSIGN, D, 0}; \
        pg8::GroupedOrder S{lctl, (size_t)D * MH * 2, 4, 0, 0, 0}; S.bind((int)gridDim.x, (int)blockIdx.x); \
        pg8::gemm_phase<pg8::EpiScaleBf16, pg8::GroupedOrder, true, true>((LAS unsigned char*)lds_raw, g, S, E); } \
    SEAM((pb) + 3);

    MOE_PHASES(0, 6)
    if (IN(10)) { const Params P = load_params(lds_raw); const Frame F = make_frame(lds_raw); ph_combine<false>(F, P, P.in[1] + D); }
    SEAM(10);
    if (IN(11)) { const Params P = load_params(lds_raw); pg8::Gemm g{WSB(WS_XN), WSB(WS_WQKV), NTOK, QKVW, D, 0}; pg8::EpiQKV E{WSB(WS_BIG), (const float*)(P.ws + WS_SMALLW + 393216), attn_body::C2, 0};
        pg8::PlainOrder S{}; S.init(NTOK, QKVW, (int)gridDim.x, (int)blockIdx.x);
        pg8::gemm_phase<pg8::EpiQKV, pg8::PlainOrder, true, true>((LAS unsigned char*)lds_raw, g, S, E); }
    SEAM(11);
    if (IN(12)) { const Params P = load_params(lds_raw); const attn_body::AttnTensors AT{(const attn_body::bf16*)WSB(WS_BIG), (const attn_body::bf16*)(WSB(WS_BIG) + 1024), (const attn_body::bf16*)(WSB(WS_BIG) + 2048), (attn_body::bf16*)WSB(WS_R3)};
        const attn_body::StaticOrder S((int)gridDim.x, (int)blockIdx.x);
        attn_body::attn_phase<attn_body::StaticOrder>((char*)lds_raw, AT, S); }
    SEAM(12);
    if (IN(13)) { const Params P = load_params(lds_raw); const Frame F = make_frame(lds_raw); ph_attn_combine(F, P); }
    SEAM(13);
    if (IN(14)) { const Params P = load_params(lds_raw); pg8::Gemm g{WSB(WS_XN), WSB(WS_CWOUT), NTOK, D, D, 0}; pg8::EpiResF32 E{P.out, P.out, D, 0}; pg8::PlainOrder S{}; S.init(NTOK, D, (int)gridDim.x, (int)blockIdx.x);
        pg8::gemm_phase<pg8::EpiResF32, pg8::PlainOrder, true, true>((LAS unsigned char*)lds_raw, g, S, E); }
    SEAM(14);
    MOE_PHASES(1, 15)
    if (IN(19)) { const Params P = load_params(lds_raw); const Frame F = make_frame(lds_raw); ph_combine<true>(F, P, P.in[3]); }
#undef MOE_PHASES
#undef IN
#undef SEAM
#undef WSB
}
}

extern "C" void kernel_launch(void* const* d_in, const int* in_sizes, int n_in, void* d_out, int out_size, void* d_ws, size_t ws_size,
                              hipStream_t stream) {
    static int grid = 0;
    if (grid == 0) {
        (void)hipFuncSetAttribute((const void*)mega, hipFuncAttributeMaxDynamicSharedMemorySize, LDS_BYTES);
        int dev = 0, cus = 0, per_cu = 0;
        (void)hipGetDevice(&dev); (void)hipDeviceGetAttribute(&cus, hipDeviceAttributeMultiprocessorCount, dev);
        (void)hipOccupancyMaxActiveBlocksPerMultiprocessor(&per_cu, (const void*)mega, 512, LDS_BYTES);
        (void)hipGetLastError();
        grid = (per_cu >= 1 && cus > 0) ? cus : 256;
    }
    (void)hipMemsetAsync((char*)d_ws + WS_CTL, 0, CTL_ZERO_BYTES, stream);
    Params P{};
    for (int i = 0; i < 33; ++i) P.in[i] = (const float*)d_in[i];
    P.out = (float*)d_out; P.ws = (unsigned char*)d_ws;
#if MK_PER_PHASE
    for (int ph = 0; ph < N_PHASES; ++ph) { P.ph_lo = ph; P.ph_hi = ph + 1; hipLaunchKernelGGL(mega, dim3(grid), dim3(512), LDS_BYTES, stream, P); }
#else
    P.ph_lo = 0; P.ph_hi = N_PHASES;
    hipLaunchKernelGGL(mega, dim3(grid), dim3(512), LDS_BYTES, stream, P);
#endif
}
```

```cpp
#define MK_PER_PHASE 0
#include <hip/hip_runtime.h>
#include <stdint.h>
#include <math.h>

#define LAS __attribute__((address_space(3)))
typedef unsigned short bf16_t;
typedef unsigned u32x4_t __attribute__((ext_vector_type(4)));
typedef unsigned u32x2_t __attribute__((ext_vector_type(2)));

namespace {
constexpr int D = 1024, SEQ = 4096, NTOK = 16384;
constexpr int RW = 512;
constexpr int SHIFTW = 1792, INW = 2304, QKVW = 3072;
constexpr int NEXP = 32, MH = 512, MBLK = 256;
constexpr int NASSIGN = NTOK * 2;
constexpr int NBLK_MAX = 159;
constexpr int PMAX = NBLK_MAX * MBLK;

__device__ __forceinline__ unsigned f2bf(float f) { unsigned u = __builtin_bit_cast(unsigned, f); return (u + 0x7fffu + ((u >> 16) & 1u)) >> 16; }
__device__ __forceinline__ unsigned pk2(float lo, float hi) { return f2bf(lo) | (f2bf(hi) << 16); }
__device__ __forceinline__ float bf2f(bf16_t b) { return __builtin_bit_cast(float, (unsigned)b << 16); }
__device__ __forceinline__ float bflo(unsigned w) { return __builtin_bit_cast(float, w << 16); }
__device__ __forceinline__ float bfhi(unsigned w) { return __builtin_bit_cast(float, w & 0xffff0000u); }

__device__ __forceinline__ float wave_sum(float v) {
#pragma unroll
    for (int o = 32; o > 0; o >>= 1) v += __shfl_xor(v, o);
    return v;
}
__device__ __forceinline__ float wave_max(float v) {
#pragma unroll
    for (int o = 32; o > 0; o >>= 1) v = fmaxf(v, __shfl_xor(v, o));
    return v;
}
__device__ __forceinline__ float block_sum(float v, float* red) {
    v = wave_sum(v);
    const int w = threadIdx.x >> 6, nw = blockDim.x >> 6;
    __syncthreads();
    if ((threadIdx.x & 63) == 0) red[w] = v;
    __syncthreads();
    float s = 0.f;
    for (int i = 0; i < nw; ++i) s += red[i];
    return s;
}
__device__ __forceinline__ float block_max(float v, float* red) {
    v = wave_max(v);
    const int w = threadIdx.x >> 6, nw = blockDim.x >> 6;
    __syncthreads();
    if ((threadIdx.x & 63) == 0) red[w] = v;
    __syncthreads();
    float s = -INFINITY;
    for (int i = 0; i < nw; ++i) s = fmaxf(s, red[i]);
    return s;
}
__device__ __forceinline__ float sigmoidf_(float x) { return 1.f / (1.f + expf(-x)); }
}
namespace pg8 {
#define PG8_LAS __attribute__((address_space(3)))
typedef unsigned short bf16_t;
typedef short bf16x8 __attribute__((ext_vector_type(8)));
typedef float f32x4 __attribute__((ext_vector_type(4)));
typedef unsigned u32x4 __attribute__((ext_vector_type(4)));
constexpr int BM = 256, BK = 64, HALF = 128, HTB = HALF * BK * 2  , STAGE_BYTES = 8 * HTB, NXCD = 8, WGM = 8;

__host__ __device__ __forceinline__ int lds_byte(int r, int c) { const int st = (r >> 4) * 2 + (c >> 5), rr = r & 15, cc = c & 31, ob = rr * 64 + cc * 2; return st * 1024 + (ob ^ (((ob >> 9) & 1) << 5)); }
__host__ __device__ __forceinline__ void stage_rc(int b, int& R, int& C) { const int st = b / 1024, sb = b % 1024, swz = sb ^ (((sb >> 9) & 1) << 5); R = (st >> 1) * 16 + swz / 64; C = (st & 1) * 32 + (swz % 64) / 2; }
__host__ __device__ __forceinline__ int perm32(int rho) { const int n = rho >> 4, i = rho & 15; return 8 * (i >> 2) + 4 * n + (i & 3); }

struct Unit { int pm, pn; size_t boff; };
struct Gemm { const bf16_t* A; const bf16_t* Bt; int M, N, K, pad; };

struct StaticOrder {
    int nM, nN, nwg, G, c, pad;
    __host__ __device__ void init(int M, int N, int G_, int c_) { nM = M / BM; nN = N / BM; nwg = nM * nN; G = G_; c = c_; }
    __host__ __device__ bool next(int i, Unit& u) const {
        const long L = (long)i * G + c; if (L >= nwg) return false;
        int wgid = (int)L; { const int q = nwg / NXCD, r = nwg % NXCD, xcd = wgid % NXCD, off = wgid / NXCD; wgid = (xcd < r ? xcd * (q + 1) : r * (q + 1) + (xcd - r) * q) + off; }
        const int nig = WGM * nN, gid = wgid / nig, fm = gid * WGM, gsz = (nM - fm) < WGM ? (nM - fm) : WGM;
        u.pm = fm + ((wgid % nig) % gsz); u.pn = (wgid % nig) / gsz; u.boff = 0; return true;
    }
    __device__ __forceinline__ void a_ready(const Unit&) const {}
    __device__ __forceinline__ void done(const Unit&) const {}
};
__device__ __forceinline__ unsigned cvt_pk_bf16(float lo, float hi) { unsigned r; asm volatile("v_cvt_pk_bf16_f32 %0, %1, %2" : "=v"(r) : "v"(lo), "v"(hi)); return r; }

struct EpiBf16Plain {
    static constexpr bool PERM = true, AFTER_DRAIN = false;
    bf16_t* O; int ldc, pad;
    __device__ __forceinline__ void operator()(const f32x4 (&acc)[2][2][4][2], const Unit& u, int wr, int wc, int fr, int fq) const {
        const int row0 = u.pm * BM + wr * 64 + fr, col0 = u.pn * BM + wc * 32 + 8 * fq;
#pragma unroll
        for (int ai = 0; ai < 2; ++ai)
#pragma unroll
            for (int m = 0; m < 4; ++m) { bf16_t* rowp = O + (size_t)(row0 + ai * HALF + m * 16) * ldc + col0;
#pragma unroll
                for (int bj = 0; bj < 2; ++bj) { const f32x4 v0 = acc[ai][bj][m][0], v1 = acc[ai][bj][m][1];
                    u32x4 w; w.x = cvt_pk_bf16(v0[0], v0[1]); w.y = cvt_pk_bf16(v0[2], v0[3]); w.z = cvt_pk_bf16(v1[0], v1[1]); w.w = cvt_pk_bf16(v1[2], v1[3]);
                    *(u32x4*)(rowp + bj * HALF) = w; } }
    }
};
struct EpiResF32 {
    static constexpr bool PERM = false, AFTER_DRAIN = false;
    const float* base; float* out; int ldc, pad;
    __device__ __forceinline__ void operator()(const f32x4 (&acc)[2][2][4][2], const Unit& u, int wr, int wc, int fr, int fq) const {
        const int row0 = u.pm * BM + wr * 64 + fr, col0 = u.pn * BM + wc * 32 + 4 * fq;
#pragma unroll
        for (int ai = 0; ai < 2; ++ai)
#pragma unroll
            for (int m = 0; m < 4; ++m) { const size_t off = (size_t)(row0 + ai * HALF + m * 16) * ldc + col0;
#pragma unroll
                for (int bj = 0; bj < 2; ++bj)
#pragma unroll
                    for (int n = 0; n < 2; ++n) { const size_t o = off + bj * HALF + n * 16; *(f32x4*)(out + o) = *(const f32x4*)(base + o) + acc[ai][bj][m][n]; } }
    }
};
__device__ __forceinline__ float silu_mul(float g, float uu) { return g * __builtin_amdgcn_rcpf(1.f + __builtin_amdgcn_exp2f(-1.4426950408889634f * g)) * uu; }
struct EpiSwiglu {
    static constexpr bool PERM = true, AFTER_DRAIN = false;
    bf16_t* H;
    __device__ __forceinline__ void operator()(const f32x4 (&acc)[2][2][4][2], const Unit& u, int wr, int wc, int fr, int fq) const {
        const int row0 = u.pm * BM + wr * 64 + fr, col0 = u.pn * 128 + wc * 32 + 8 * fq;
#pragma unroll
        for (int ai = 0; ai < 2; ++ai)
#pragma unroll
            for (int m = 0; m < 4; ++m) { bf16_t* rowp = H + (size_t)(row0 + ai * HALF + m * 16) * 512 + col0;
                const f32x4 g0 = acc[ai][0][m][0], g1 = acc[ai][0][m][1], u0 = acc[ai][1][m][0], u1 = acc[ai][1][m][1];
                u32x4 w; w.x = cvt_pk_bf16(silu_mul(g0[0], u0[0]), silu_mul(g0[1], u0[1])); w.y = cvt_pk_bf16(silu_mul(g0[2], u0[2]), silu_mul(g0[3], u0[3]));
                w.z = cvt_pk_bf16(silu_mul(g1[0], u1[0]), silu_mul(g1[1], u1[1])); w.w = cvt_pk_bf16(silu_mul(g1[2], u1[2]), silu_mul(g1[3], u1[3]));
                *(u32x4*)rowp = w; }
    }
};

struct EpiQKV {
    static constexpr bool PERM = true, AFTER_DRAIN = false;
    bf16_t* O; const float* cs; float qscale; int pad;
    __device__ __forceinline__ void operator()(const f32x4 (&acc)[2][2][4][2], const Unit& u, int wr, int wc, int fr, int fq) const {
        const int row0 = u.pm * BM + wr * 64 + fr, col0 = u.pn * BM + wc * 32 + 8 * fq;
        const bool rope = (u.pn < 8) && ((wc & 1) == 0);
        const float sc = (u.pn < 4) ? qscale : 1.f;
        const float sgn = (fq == 0) ? -1.f : 1.f; const bool act = fq < 2;
#pragma unroll
        for (int ai = 0; ai < 2; ++ai)
#pragma unroll
            for (int m = 0; m < 4; ++m) { const int row = row0 + ai * HALF + m * 16; bf16_t* rowp = O + (size_t)row * 3072 + col0;
                f32x4 cs0 = {1.f, 0.f, 1.f, 0.f}, cs1 = cs0, cs2 = cs0, cs3 = cs0;
                if (rope) { const f32x4* cp = (const f32x4*)(cs + (size_t)(row & 4095) * 16); cs0 = cp[0]; cs1 = cp[1]; cs2 = cp[2]; cs3 = cp[3]; }
#pragma unroll
                for (int bj = 0; bj < 2; ++bj) { f32x4 v0 = acc[ai][bj][m][0], v1 = acc[ai][bj][m][1];
                    if (rope) {
                        f32x4 p0, p1;
#pragma unroll
                        for (int j = 0; j < 4; ++j) { p0[j] = __shfl_xor(v0[j], 16); p1[j] = __shfl_xor(v1[j], 16); }
                        if (act) {
                            v0[0] = v0[0] * cs0[0] + sgn * p0[0] * cs0[1]; v0[1] = v0[1] * cs0[2] + sgn * p0[1] * cs0[3];
                            v0[2] = v0[2] * cs1[0] + sgn * p0[2] * cs1[1]; v0[3] = v0[3] * cs1[2] + sgn * p0[3] * cs1[3];
                            v1[0] = v1[0] * cs2[0] + sgn * p1[0] * cs2[1]; v1[1] = v1[1] * cs2[2] + sgn * p1[1] * cs2[3];
                            v1[2] = v1[2] * cs3[0] + sgn * p1[2] * cs3[1]; v1[3] = v1[3] * cs3[2] + sgn * p1[3] * cs3[3];
                        }
                    }
                    v0 = v0 * sc; v1 = v1 * sc;
                    u32x4 w; w.x = cvt_pk_bf16(v0[0], v0[1]); w.y = cvt_pk_bf16(v0[2], v0[3]); w.z = cvt_pk_bf16(v1[0], v1[1]); w.w = cvt_pk_bf16(v1[2], v1[3]);
                    *(u32x4*)(rowp + bj * HALF) = w; }
                asm volatile("" ::: "memory"); }
    }
};
struct EpiScaleBf16 {
    static constexpr bool PERM = true, AFTER_DRAIN = false;
    bf16_t* O; const float* rs; int ldc, pad;
    __device__ __forceinline__ void operator()(const f32x4 (&acc)[2][2][4][2], const Unit& u, int wr, int wc, int fr, int fq) const {
        const int row0 = u.pm * BM + wr * 64 + fr, col0 = u.pn * BM + wc * 32 + 8 * fq;
#pragma unroll
        for (int ai = 0; ai < 2; ++ai)
#pragma unroll
            for (int m = 0; m < 4; ++m) { const int row = row0 + ai * HALF + m * 16; const float s = rs[row]; bf16_t* rowp = O + (size_t)row * ldc + col0;
#pragma unroll
                for (int bj = 0; bj < 2; ++bj) { const f32x4 v0 = acc[ai][bj][m][0] * s, v1 = acc[ai][bj][m][1] * s;
                    u32x4 w; w.x = cvt_pk_bf16(v0[0], v0[1]); w.y = cvt_pk_bf16(v0[2], v0[3]); w.z = cvt_pk_bf16(v1[0], v1[1]); w.w = cvt_pk_bf16(v1[2], v1[3]);
                    *(u32x4*)(rowp + bj * HALF) = w; } }
    }
};
struct GroupedOrder {
    const int* ctl; size_t estride; int nN, G, v, pad;
    __device__ __forceinline__ void bind(int G_, int c) { G = G_; v = (G_ % 8 == 0) ? (c % 8) * (G_ / 8) + c / 8 : c; }
    __device__ __forceinline__ bool next(int i, Unit& u) const {
        const int nblk = __builtin_amdgcn_readfirstlane(__hip_atomic_load(ctl + 96, __ATOMIC_RELAXED, __HIP_MEMORY_SCOPE_AGENT));
        const long L = (long)i * G + v; if (L >= (long)nblk * nN) return false;
        u.pm = (int)(L / nN); u.pn = (int)(L % nN);
        u.boff = (size_t)__builtin_amdgcn_readfirstlane(__hip_atomic_load(ctl + 128 + u.pm, __ATOMIC_RELAXED, __HIP_MEMORY_SCOPE_AGENT)) * estride; return true; }
    __device__ __forceinline__ void a_ready(const Unit&) const {}
    __device__ __forceinline__ void done(const Unit&) const {}
};
struct PlainOrder : StaticOrder {
    __device__ __forceinline__ void bind(int G_, int c_) { G = G_; c = c_; }
};
template <class Epi, class Sched, bool ALIGN_EPI = false, bool SP2 = false>
__device__ __forceinline__ void gemm_phase(PG8_LAS unsigned char* lds, const Gemm g, const Sched& S, const Epi& E) {
    const int tid = threadIdx.x, wid = __builtin_amdgcn_readfirstlane(tid >> 6), lane = tid & 63, wr = wid >> 2, wc = wid & 3, fr = lane & 15, fq = lane >> 4;
    const int K = g.K, nt = K / BK;
    unsigned voffA[2], voffB[2];
#pragma unroll
    for (int i = 0; i < 2; ++i) { int R, C; stage_rc(tid * 16 + i * 8192, R, C); const int Rb = Epi::PERM ? ((R & ~31) + perm32(R & 31)) : R;
        voffA[i] = (unsigned)(R * K + C) * 2u; voffB[i] = (unsigned)(Rb * K + C) * 2u; }
    const size_t kstep = (size_t)(BK * 2);
    const size_t hstep = (size_t)HALF * K * 2;
    const size_t tstep = 2 * hstep;
    const unsigned ldsw = (unsigned)wid * 1024u;
    const int aoff = lds_byte(wr * 64 + fr, fq * 8), boff = lds_byte(wc * 32 + fr, fq * 8);
#define PG8_SA(b, h) (((b) * 2 + (h)) * HTB)
#define PG8_SB(b, h) ((4 + (b) * 2 + (h)) * HTB)
#define PG8_STAGE(bufoff, gbase, voff) do { _Pragma("unroll") for (int _i = 0; _i < 2; ++_i) \
        __builtin_amdgcn_global_load_lds((const unsigned*)((const char*)(gbase) + (voff)[_i]), (PG8_LAS unsigned*)(lds + (bufoff) + ldsw + _i * 8192), 16, 0, 0); } while (0)
#define PG8_LDA(dst, b, h) do { _Pragma("unroll") for (int m = 0; m < 4; ++m) _Pragma("unroll") for (int k = 0; k < 2; ++k) dst[m][k] = *(const PG8_LAS bf16x8*)(lds + PG8_SA(b, h) + aoff + m * 2048 + k * 1024); } while (0)
#define PG8_LDB(dst, b, h) do { _Pragma("unroll") for (int n = 0; n < 2; ++n) _Pragma("unroll") for (int k = 0; k < 2; ++k) dst[n][k] = *(const PG8_LAS bf16x8*)(lds + PG8_SB(b, h) + boff + n * 2048 + k * 1024); } while (0)
#define PG8_MMA(ai, bj, At, Bt) do { __builtin_amdgcn_s_setprio(1); _Pragma("unroll") for (int m = 0; m < 4; ++m) _Pragma("unroll") for (int n = 0; n < 2; ++n) _Pragma("unroll") for (int k = 0; k < 2; ++k) \
        acc[ai][bj][m][n] = __builtin_amdgcn_mfma_f32_16x16x32_bf16(Bt[n][k], At[m][k], acc[ai][bj][m][n], 0, 0, 0); __builtin_amdgcn_s_setprio(0); } while (0)
#define PG8_WAIT_V(n) asm volatile("s_waitcnt vmcnt(" #n ")" ::: "memory")
#define PG8_WAIT_L(n) asm volatile("s_waitcnt lgkmcnt(" #n ")" ::: "memory")
#define PG8_BAR __builtin_amdgcn_s_barrier()
#define PG8_SCHED __builtin_amdgcn_sched_barrier(0)
    Unit cur, nxt; int ui = 0;
    if (!S.next(0, cur)) return;
    f32x4 acc[2][2][4][2];
#pragma unroll
    for (int a = 0; a < 2; ++a)
#pragma unroll
        for (int b = 0; b < 2; ++b)
#pragma unroll
            for (int m = 0; m < 4; ++m)
#pragma unroll
                for (int n = 0; n < 2; ++n) acc[a][b][m][n] = (f32x4){0.f, 0.f, 0.f, 0.f};
    bf16x8 At[4][2], B0[2][2], B1[2][2];
    const char* cA = (const char*)g.A + (size_t)cur.pm * tstep; const char* cB = (const char*)g.Bt + cur.boff + (size_t)cur.pn * tstep;
    S.a_ready(cur);
    if constexpr (SP2) {
        PG8_STAGE(PG8_SB(0, 0), cB, voffB); PG8_STAGE(PG8_SB(0, 1), cB + hstep, voffB); PG8_STAGE(PG8_SA(0, 0), cA, voffA); PG8_STAGE(PG8_SA(0, 1), cA + hstep, voffA);
        if (wr == 1) PG8_BAR;
        PG8_WAIT_V(2); PG8_BAR;
        PG8_STAGE(PG8_SB(1, 0), cB + kstep, voffB); PG8_STAGE(PG8_SA(1, 0), cA + kstep, voffA); PG8_STAGE(PG8_SB(1, 1), cB + hstep + kstep, voffB);
        PG8_WAIT_V(6); PG8_BAR;
    } else {
        PG8_STAGE(PG8_SB(0, 0), cB, voffB); PG8_STAGE(PG8_SA(0, 0), cA, voffA); PG8_STAGE(PG8_SB(0, 1), cB + hstep, voffB); PG8_STAGE(PG8_SA(0, 1), cA + hstep, voffA);
        if (wr == 1) PG8_BAR;
        PG8_WAIT_V(4); PG8_BAR;
        PG8_STAGE(PG8_SB(1, 0), cB + kstep, voffB); PG8_STAGE(PG8_SA(1, 0), cA + kstep, voffA); PG8_STAGE(PG8_SB(1, 1), cB + hstep + kstep, voffB);
        PG8_WAIT_V(6); PG8_BAR;
    }
    for (;;) {
        const bool has_next = S.next(ui + 1, nxt);
        const char* nA = has_next ? (const char*)g.A + (size_t)nxt.pm * tstep : cA; const char* nB = has_next ? (const char*)g.Bt + nxt.boff + (size_t)nxt.pn * tstep : cB;
        for (int t = 0; t < nt; t += 2) {
            const bool last = (t == nt - 2);
            const char* a1 = cA + (size_t)(t + 1) * kstep;
            const char* a2 = last ? nA : cA + (size_t)(t + 2) * kstep; const char* b2 = last ? nB : cB + (size_t)(t + 2) * kstep;
            const char* a3 = a2 + kstep; const char* b3 = b2 + kstep;
            if (last && has_next) S.a_ready(nxt);
            if constexpr (SP2) {
            PG8_LDB(B0, 0, 0); PG8_LDB(B1, 0, 1); PG8_SCHED; PG8_LDA(At, 0, 0); PG8_STAGE(PG8_SA(1, 1), a1 + hstep, voffA);
            PG8_WAIT_V(8); PG8_WAIT_L(0); PG8_BAR; PG8_MMA(0, 0, At, B0); PG8_MMA(0, 1, At, B1); PG8_BAR; PG8_SCHED;
            PG8_LDA(At, 0, 1); PG8_STAGE(PG8_SB(0, 0), b2, voffB); PG8_STAGE(PG8_SB(0, 1), b2 + hstep, voffB); PG8_STAGE(PG8_SA(0, 0), a2, voffA);
            PG8_WAIT_V(8); PG8_WAIT_L(0); PG8_BAR; PG8_MMA(1, 0, At, B0); PG8_MMA(1, 1, At, B1); PG8_BAR; PG8_SCHED;
            PG8_LDB(B0, 1, 0); PG8_LDB(B1, 1, 1); PG8_SCHED; PG8_LDA(At, 1, 0); PG8_STAGE(PG8_SA(0, 1), a2 + hstep, voffA);
            PG8_WAIT_V(8); PG8_WAIT_L(0); PG8_BAR; PG8_MMA(0, 0, At, B0); PG8_MMA(0, 1, At, B1); PG8_BAR; PG8_SCHED;
            PG8_LDA(At, 1, 1); PG8_STAGE(PG8_SB(1, 0), b3, voffB); PG8_STAGE(PG8_SB(1, 1), b3 + hstep, voffB); PG8_STAGE(PG8_SA(1, 0), a3, voffA);
            PG8_WAIT_V(8); PG8_WAIT_L(0); PG8_BAR; PG8_MMA(1, 0, At, B0); PG8_MMA(1, 1, At, B1); PG8_BAR; PG8_SCHED;
            } else {
            PG8_LDB(B0, 0, 0); PG8_SCHED; PG8_LDA(At, 0, 0); PG8_STAGE(PG8_SA(1, 1), a1 + hstep, voffA);
            PG8_WAIT_L(8); PG8_BAR; PG8_WAIT_L(0); PG8_MMA(0, 0, At, B0); PG8_BAR; PG8_SCHED;
            PG8_LDB(B1, 0, 1); PG8_STAGE(PG8_SB(0, 0), b2, voffB);
            PG8_BAR; PG8_WAIT_L(0); PG8_MMA(0, 1, At, B1); PG8_BAR;
            PG8_LDA(At, 0, 1); PG8_STAGE(PG8_SA(0, 0), a2, voffA);
            PG8_BAR; PG8_WAIT_L(0); PG8_MMA(1, 0, At, B0); PG8_BAR; PG8_SCHED;
            PG8_STAGE(PG8_SB(0, 1), b2 + hstep, voffB);
            PG8_WAIT_V(6); PG8_BAR; PG8_MMA(1, 1, At, B1); PG8_BAR;
            PG8_LDB(B0, 1, 0); PG8_SCHED; PG8_LDA(At, 1, 0); PG8_STAGE(PG8_SA(0, 1), a2 + hstep, voffA);
            PG8_WAIT_L(8); PG8_BAR; PG8_WAIT_L(0); PG8_MMA(0, 0, At, B0); PG8_BAR; PG8_SCHED;
            PG8_LDB(B1, 1, 1); PG8_STAGE(PG8_SB(1, 0), b3, voffB);
            PG8_BAR; PG8_WAIT_L(0); PG8_MMA(0, 1, At, B1); PG8_BAR;
            PG8_LDA(At, 1, 1); PG8_STAGE(PG8_SA(1, 0), a3, voffA);
            PG8_BAR; PG8_WAIT_L(0); PG8_MMA(1, 0, At, B0); PG8_BAR; PG8_SCHED;
            PG8_STAGE(PG8_SB(1, 1), b3 + hstep, voffB);
            PG8_WAIT_V(6); PG8_BAR; PG8_MMA(1, 1, At, B1); PG8_BAR;
            }
        }
        if constexpr (ALIGN_EPI) { if (wr == 0) PG8_BAR; }
        if constexpr (!Epi::AFTER_DRAIN) { E(acc, cur, wr, wc, fr, fq); S.done(cur); }
        if (!has_next) break;
#pragma unroll
        for (int a = 0; a < 2; ++a)
#pragma unroll
            for (int b = 0; b < 2; ++b)
#pragma unroll
                for (int m = 0; m < 4; ++m)
#pragma unroll
                    for (int n = 0; n < 2; ++n) acc[a][b][m][n] = (f32x4){0.f, 0.f, 0.f, 0.f};
        cur = nxt; cA = nA; cB = nB; ++ui;
        if constexpr (ALIGN_EPI) { if (wr == 1) PG8_BAR; }
    }
    PG8_WAIT_V(0);
    if constexpr (!ALIGN_EPI) { if (wr == 0) PG8_BAR; }
    PG8_BAR;
    if constexpr (Epi::AFTER_DRAIN) { E.fused(acc, cur, wr, wc, fr, fq, lds, wid, lane); S.done(cur); }
#undef PG8_SA
#undef PG8_SB
#undef PG8_STAGE
#undef PG8_LDA
#undef PG8_LDB
#undef PG8_MMA
#undef PG8_WAIT_V
#undef PG8_WAIT_L
#undef PG8_BAR
#undef PG8_SCHED
}
}
#include <hip/hip_bf16.h>
#include <cmath>
namespace attn_body {
using bf16=__hip_bfloat16;
using bf16x8=__attribute__((ext_vector_type(8)))short;
using s16x4=__attribute__((ext_vector_type(4)))short;
using f32x16=__attribute__((ext_vector_type(16)))float;
using u32x4=__attribute__((ext_vector_type(4)))unsigned;
constexpr int BATCH=4,NHEAD=32,SEQ=4096,D=64,DM=3072,DMO=2048;
constexpr int NW=8,QBLK=32,QB=QBLK*NW,KVBLK=64,NQB=SEQ/QB;
constexpr int ATTN_PITCH=DM, ATTN_UNIT_ROWS=QB;
__device__ __forceinline__ int crow(int r,int hi){return (r&3)+8*(r>>2)+4*hi;}
#define SBAR() __builtin_amdgcn_sched_barrier(0)
__device__ __forceinline__ void cmask(f32x16&p0,f32x16&p1,int jb,int qrel,int hi){
  const float NEG=-INFINITY; int kb=64*jb+4*hi;
  #pragma unroll
  for(int r=0;r<16;++r){int kv=kb+(r&3)+8*(r>>2); if(kv>qrel)p0[r]=NEG; if(kv+32>qrel)p1[r]=NEG;}
}

constexpr int NSLOT=3, SLOTB=8192;
constexpr int LDS_K=0, LDS_V=NSLOT*SLOTB, LDS_WS=2*NSLOT*SLOTB, LDS_OST=LDS_WS+NW*64*4, LDS_BYTES=LDS_OST+NW*4096;
constexpr float C2=0.125f*1.4426950408889634f;
__device__ __forceinline__ void glds16(const void*gsrc,unsigned lds_dst){unsigned keep;
  asm volatile("s_mov_b32 %0, m0\n\ts_mov_b32 m0, %2\n\ts_nop 0\n\tglobal_load_lds_dwordx4 %1, off\n\ts_mov_b32 m0, %0":"=&s"(keep):"v"(gsrc),"s"(lds_dst):"memory");}
__device__ __forceinline__ float max3f(float a,float b,float c){float r;asm("v_max3_f32 %0, %1, %2, %3":"=v"(r):"v"(a),"v"(b),"v"(c));return r;}
__device__ __forceinline__ float max2f(float a,float b){float r;asm("v_max_f32_e32 %0, %1, %2":"=v"(r):"v"(a),"v"(b));return r;}
__device__ __forceinline__ float fadd_s(float a,float b){float r;asm("v_add_f32_e32 %0, %1, %2":"=v"(r):"v"(a),"v"(b));return r;}
__device__ __forceinline__ float fsub_s(float a,float b){float r;asm("v_sub_f32_e32 %0, %1, %2":"=v"(r):"v"(a),"v"(b));return r;}
typedef float f32x2_t __attribute__((ext_vector_type(2))); typedef __bf16 bf16x2_t __attribute__((ext_vector_type(2)));
__device__ __forceinline__ unsigned cvtpk_s(float lo,float hi){f32x2_t v={lo,hi};bf16x2_t b=__builtin_convertvector(v,bf16x2_t);return __builtin_bit_cast(unsigned,b);}
#define WAIT_BAR(N) asm volatile("s_waitcnt vmcnt(" #N ") lgkmcnt(0)\n\ts_barrier":::"memory")

__device__ __forceinline__ void qkt(f32x16&p0,f32x16&p1,const char*Kslot,const bf16x8*qr,const f32x16&negm,int r32,int hi){
  const char*kb=Kslot+hi*1024+r32*16;
  #pragma unroll
  for(int d0=0;d0<4;++d0){
    const bf16x8 b0=*reinterpret_cast<const bf16x8*>(kb+d0*2048);
    const bf16x8 b1=*reinterpret_cast<const bf16x8*>(kb+d0*2048+512);
    if(d0==0){p0=__builtin_amdgcn_mfma_f32_32x32x16_bf16(b0,qr[0],negm,0,0,0);p1=__builtin_amdgcn_mfma_f32_32x32x16_bf16(b1,qr[0],negm,0,0,0);}
    else{p0=__builtin_amdgcn_mfma_f32_32x32x16_bf16(b0,qr[d0],p0,0,0,0);p1=__builtin_amdgcn_mfma_f32_32x32x16_bf16(b1,qr[d0],p1,0,0,0);}}
}
typedef __attribute__((address_space(3))) const char* lds_cptr;
typedef short v4i16_t __attribute__((ext_vector_type(4)));
__device__ __forceinline__ void kload8(bf16x8*kf,lds_cptr kp){
  kf[0]=*(const __attribute__((address_space(3))) bf16x8*)(kp);      kf[1]=*(const __attribute__((address_space(3))) bf16x8*)(kp+512);
  kf[2]=*(const __attribute__((address_space(3))) bf16x8*)(kp+2048); kf[3]=*(const __attribute__((address_space(3))) bf16x8*)(kp+2560);
  kf[4]=*(const __attribute__((address_space(3))) bf16x8*)(kp+4096); kf[5]=*(const __attribute__((address_space(3))) bf16x8*)(kp+4608);
  kf[6]=*(const __attribute__((address_space(3))) bf16x8*)(kp+6144); kf[7]=*(const __attribute__((address_space(3))) bf16x8*)(kp+6656);
}
__device__ __forceinline__ void kload2(bf16x8*kf,lds_cptr kp,int j){ kf[2*j]=*(const __attribute__((address_space(3))) bf16x8*)(kp+j*2048); kf[2*j+1]=*(const __attribute__((address_space(3))) bf16x8*)(kp+j*2048+512); }
__device__ __forceinline__ s16x4 vtr(lds_cptr p){ return __builtin_bit_cast(s16x4,__builtin_amdgcn_ds_read_tr16_b64_v4i16((__attribute__((address_space(3))) v4i16_t*)p)); }
__device__ __forceinline__ float rowmax(const f32x16&p0,const f32x16&p1){
  float a=max3f(p0[0],p0[1],p1[0]),b=max3f(p0[2],p0[3],p1[1]);a=max3f(a,p1[2],p1[3]);
  #pragma unroll
  for(int r=4;r<16;r+=4){a=max3f(a,p0[r],p0[r+1]);b=max3f(b,p0[r+2],p0[r+3]);a=max3f(a,p1[r],p1[r+1]);b=max3f(b,p1[r+2],p1[r+3]);}
  const float m=max2f(a,b);
  auto rr=__builtin_amdgcn_permlane32_swap(__float_as_uint(m),__float_as_uint(m),false,false);
  return max2f(__uint_as_float(rr[0]),__uint_as_float(rr[1]));
}
__device__ __forceinline__ void pv(f32x16*o,int vb,bf16x8 pa0,bf16x8 pa1,bf16x8 pa2,bf16x8 pa3){
  #pragma unroll
  for(int d0=0;d0<2;++d0){s16x4 lo[4],hi[4];
    #pragma unroll
    for(int ks=0;ks<4;++ks){
      asm volatile("ds_read_b64_tr_b16 %0,%1 offset:%c2":"=&v"(lo[ks]):"v"(vb),"i"(d0*4096+ks*1024):"memory");
      asm volatile("ds_read_b64_tr_b16 %0,%1 offset:%c2":"=&v"(hi[ks]):"v"(vb),"i"(d0*4096+ks*1024+512):"memory");}
    asm volatile("s_waitcnt lgkmcnt(0)":::"memory");SBAR();
    #define PK(k) (bf16x8){lo[k][0],lo[k][1],lo[k][2],lo[k][3],hi[k][0],hi[k][1],hi[k][2],hi[k][3]}
    o[d0]=__builtin_amdgcn_mfma_f32_32x32x16_bf16(pa0,PK(0),o[d0],0,0,0);
    o[d0]=__builtin_amdgcn_mfma_f32_32x32x16_bf16(pa1,PK(1),o[d0],0,0,0);
    o[d0]=__builtin_amdgcn_mfma_f32_32x32x16_bf16(pa2,PK(2),o[d0],0,0,0);
    o[d0]=__builtin_amdgcn_mfma_f32_32x32x16_bf16(pa3,PK(3),o[d0],0,0,0);
    #undef PK
  }
}

#ifndef ATTN_STORE16
#define ATTN_STORE16(p,v) (*(u32x4*)(p)=(v))
#endif
template<int THRL> __device__ __forceinline__ void attn_unit(int b,int h,int qb,const bf16*Q,const bf16*__restrict__ K,const bf16*__restrict__ V,bf16*O,char*shm){
  const int tid=threadIdx.x,lane=tid&63,r32=lane&31,hi=lane>>5; const int wid=__builtin_amdgcn_readfirstlane(tid>>6);
  const long rowbase=(long)b*SEQ; const int q0=qb*QB;
  const bf16*Qw=Q+(rowbase+q0+wid*QBLK)*DM+(h>>1)*D;
  const bf16*Kh=K+rowbase*DM+(h>>1)*D,*Vh=V+rowbase*DM+((h>>2)*2+(h&1))*D;
  const unsigned lds0=(unsigned)(uintptr_t)shm;
  float*wsf=(float*)(shm+LDS_WS)+wid*64;
  const bf16*ksrc=Kh+(long)lane*DM+wid*8;
  const bf16*vsrc=Vh+(long)(16*(wid&3)+(lane>>2))*DM+(wid>>2)*32+(lane&3)*8;
  const unsigned kdst=lds0+LDS_K+wid*1024, vdst=lds0+LDS_V+wid*1024;
  #define DMA_K(t,slot) glds16(ksrc+(long)(t)*KVBLK*DM,(unsigned)__builtin_amdgcn_readfirstlane(kdst+(slot)))
  #define DMA_V(t,slot) glds16(vsrc+(long)(t)*KVBLK*DM,(unsigned)__builtin_amdgcn_readfirstlane(vdst+(slot)))
  const int vb0=(int)(lds0+LDS_V)+((lane>>4)&1)*32+(lane&3)*8+(4*hi+((lane&15)>>2))*64;
  const char*Kbase=shm+LDS_K; bf16x8 kf[8];
  const lds_cptr shm3=(lds_cptr)shm; const lds_cptr kp0=shm3+LDS_K+hi*1024+r32*16; const lds_cptr vp0=shm3+LDS_V+((lane>>4)&1)*32+(lane&3)*8+(4*hi+((lane&15)>>2))*64;
  const int NT=(q0+QB)/KVBLK;
  DMA_K(0,0);DMA_V(0,0);DMA_K(1,SLOTB);
  bf16x8 qr[4];
  #pragma unroll
  for(int d0=0;d0<4;++d0)qr[d0]=*reinterpret_cast<const bf16x8*>(&Qw[(long)r32*DM+d0*16+hi*8]);
  float mhat=0.f,l_reg=0.f;f32x16 o[2];o[0]=f32x16{};o[1]=f32x16{};f32x16 negm=f32x16{};asm volatile("":"+v"(negm));
  const int qrel=wid*QBLK+r32;
  #define CMASK(P0,P1,t) do{int jb_=(t)-(NT-4); if(jb_>=0)cmask(P0,P1,jb_,qrel,hi);}while(0)
  bool resc=false;
  #define START(P0,P1) do{ const float rm=rowmax(P0,P1); resc=false; \
    { const float dl=rm; mhat=fadd_s(mhat,dl); \
      _Pragma("unroll") for(int r=0;r<16;++r){P0[r]=fsub_s(P0[r],dl);P1[r]=fsub_s(P1[r],dl);} \
      _Pragma("unroll") for(int r=0;r<16;++r)negm[r]=-mhat; asm volatile("":"+v"(negm)); } \
    _Pragma("unroll") for(int r=0;r<16;++r)P0[r]=__builtin_amdgcn_exp2f(P0[r]); }while(0)
  #define RESC() do{ if(resc){ asm volatile("s_waitcnt lgkmcnt(0)":::"memory"); \
      _Pragma("unroll") for(int d_=0;d_<2;++d_) _Pragma("unroll") for(int r=0;r<16;++r)o[d_][r]*=wsf[crow(r,hi)]; } }while(0)
  f32x16 pA0,pA1,pB0,pB1;
  int sl_prev=0,sl_cur=0,sl_next=SLOTB;
  #define ROT() do{sl_prev=sl_cur;sl_cur=sl_next;sl_next=(sl_next==(NSLOT-1)*SLOTB)?0:sl_next+SLOTB;}while(0)
  DMA_K(2,2*SLOTB);
  WAIT_BAR(3);
  qkt(pA0,pA1,Kbase,qr,negm,r32,hi);asm volatile("s_nop 15\n\ts_nop 7":"+v"(pA0),"+v"(pA1));CMASK(pA0,pA1,0);
  START(pA0,pA1);
  _Pragma("unroll") for(int r=0;r<16;++r)pA1[r]=__builtin_amdgcn_exp2f(pA1[r]);
  WAIT_BAR(0);
  DMA_K(3,0);DMA_V(1,SLOTB);
  ROT();
  kload8(kf,kp0+sl_cur);
  WAIT_BAR(2);
  s16x4 vlo[8],vhi[8]; u32x4 pw0,pw1,pw2,pw3;
  #define PKW(P,B) cvtpk_s(P[B],P[B+1])
  #define PAF(k) __builtin_bit_cast(bf16x8,pw##k)
  #define VFR(i) (bf16x8){vlo[i][0],vlo[i][1],vlo[i][2],vlo[i][3],vhi[i][0],vhi[i][1],vhi[i][2],vhi[i][3]}
  #define PIN(x) asm volatile("":"+v"(x))
  #define MX3(a,b,c) __builtin_fmaxf(__builtin_fmaxf((a),(b)),(c))
  #define GAPA(MF,A0,A1,A2,A3,W0,W1,PW) do{ MF; sacc+=A0; sacc+=A1; sacc+=A2; sacc+=A3; PIN(sacc); W0; W1; PIN(PW); SBAR(); }while(0)
  #define EX(v) __builtin_amdgcn_exp2f(v)
  #define GAPB(MF,X,B) do{ MF; X[B]=EX(X[B]); X[B+1]=EX(X[B+1]); X[B+2]=EX(X[B+2]); X[B+3]=EX(X[B+3]); PIN(X); SBAR(); }while(0)
  #define VRD(i) do{ vlo[i]=vtr(vp_+(((i)>>2)*4096+((i)&3)*1024)); vhi[i]=vtr(vp_+(((i)>>2)*4096+((i)&3)*1024+512)); }while(0)
  #define KRD(G,j) do{ if(G){ kload2(kf,kp0+sl_next,j); SBAR(); } }while(0)
  #define STEP(C0,C1,P0,P1,t,GK,GV,GL) do{ SBAR(); \
    const lds_cptr vp_=vp0+sl_prev; \
    VRD(0); SBAR(); float sacc=(P0[0]+P0[1]); \
    GAPA(C0=__builtin_amdgcn_mfma_f32_32x32x16_bf16(kf[0],qr[0],negm,0,0,0), P0[2],P0[3],P0[4],P0[5],     pw0[0]=PKW(P0,0), pw0[1]=PKW(P0,2), pw0); \
    VRD(4); SBAR(); GAPA(C1=__builtin_amdgcn_mfma_f32_32x32x16_bf16(kf[1],qr[0],negm,0,0,0), P0[6],P0[7],P0[8],P0[9],     pw0[2]=PKW(P0,4), pw0[3]=PKW(P0,6), pw0); \
    VRD(1); SBAR(); GAPA(C0=__builtin_amdgcn_mfma_f32_32x32x16_bf16(kf[2],qr[1],C0,0,0,0),   P0[10],P0[11],P0[12],P0[13], pw1[0]=PKW(P0,8), pw1[1]=PKW(P0,10), pw1); \
    VRD(5); SBAR(); GAPA(C1=__builtin_amdgcn_mfma_f32_32x32x16_bf16(kf[3],qr[1],C1,0,0,0),   P0[14],P0[15],P1[0],P1[1],   pw1[2]=PKW(P0,12),pw1[3]=PKW(P0,14), pw1); \
    VRD(2); SBAR(); GAPA(C0=__builtin_amdgcn_mfma_f32_32x32x16_bf16(kf[4],qr[2],C0,0,0,0),   P1[2],P1[3],P1[4],P1[5],     pw2[0]=PKW(P1,0), pw2[1]=PKW(P1,2), pw2); \
    VRD(6); SBAR(); GAPA(C1=__builtin_amdgcn_mfma_f32_32x32x16_bf16(kf[5],qr[2],C1,0,0,0),   P1[6],P1[7],P1[8],P1[9],     pw2[2]=PKW(P1,4), pw2[3]=PKW(P1,6), pw2); \
    VRD(3); SBAR(); GAPA(C0=__builtin_amdgcn_mfma_f32_32x32x16_bf16(kf[6],qr[3],C0,0,0,0),   P1[10],P1[11],P1[12],P1[13], pw3[0]=PKW(P1,8), pw3[1]=PKW(P1,10), pw3); \
    VRD(7); SBAR(); GAPA(C1=__builtin_amdgcn_mfma_f32_32x32x16_bf16(kf[7],qr[3],C1,0,0,0),   P1[14],P1[15],0.f,0.f,       pw3[2]=PKW(P1,12),pw3[3]=PKW(P1,14), pw3); \
    l_reg+=sacc; \
    if(GK){DMA_K((t)+3,sl_cur);} if(GV){DMA_V((t)+1,sl_next);} \
    CMASK(C0,C1,t); \
    { float a=MX3(C0[0],C0[1],C1[0]),b=MX3(C0[2],C0[3],C1[1]); a=MX3(a,C1[2],C1[3]); \
      _Pragma("unroll") for(int r=4;r<16;r+=4){a=MX3(a,C0[r],C0[r+1]);b=MX3(b,C0[r+2],C0[r+3]);a=MX3(a,C1[r],C1[r+1]);b=MX3(b,C1[r+2],C1[r+3]);} \
      float rm=__builtin_fmaxf(a,b); { auto rr=__builtin_amdgcn_permlane32_swap(__float_as_uint(rm),__float_as_uint(rm),false,false); rm=__builtin_fmaxf(__uint_as_float(rr[0]),__uint_as_float(rr[1])); } \
      resc=false; \
      if(__builtin_expect(__any(rm>(float)THRL),0)){ const float dl=__builtin_fmaxf(rm,0.f); mhat+=dl; \
        _Pragma("unroll") for(int r=0;r<16;++r){C0[r]-=dl;C1[r]-=dl;} \
        _Pragma("unroll") for(int r=0;r<16;++r)negm[r]=-mhat; asm volatile("":"+v"(negm)); \
        const float f=__builtin_amdgcn_exp2f(-dl); l_reg*=f; if(hi==0)wsf[r32]=f; resc=true; } } \
    SBAR(); \
    GAPB(o[0]=__builtin_amdgcn_mfma_f32_32x32x16_bf16(PAF(0),VFR(0),o[0],0,0,0), C0,0); \
    GAPB(o[1]=__builtin_amdgcn_mfma_f32_32x32x16_bf16(PAF(0),VFR(4),o[1],0,0,0), C0,4); \
    KRD(GL,0); GAPB(o[0]=__builtin_amdgcn_mfma_f32_32x32x16_bf16(PAF(1),VFR(1),o[0],0,0,0), C0,8); \
    KRD(GL,1); GAPB(o[1]=__builtin_amdgcn_mfma_f32_32x32x16_bf16(PAF(1),VFR(5),o[1],0,0,0), C0,12); \
    KRD(GL,2); GAPB(o[0]=__builtin_amdgcn_mfma_f32_32x32x16_bf16(PAF(2),VFR(2),o[0],0,0,0), C1,0); \
    KRD(GL,3); GAPB(o[1]=__builtin_amdgcn_mfma_f32_32x32x16_bf16(PAF(2),VFR(6),o[1],0,0,0), C1,4); \
    GAPB(o[0]=__builtin_amdgcn_mfma_f32_32x32x16_bf16(PAF(3),VFR(3),o[0],0,0,0), C1,8); \
    GAPB(o[1]=__builtin_amdgcn_mfma_f32_32x32x16_bf16(PAF(3),VFR(7),o[1],0,0,0), C1,12); \
    }while(0)
  int t=1;
  #undef CMASK
  #define CMASK(P0,P1,t) do{}while(0)
  for(;t+5<NT;t+=2){
    STEP(pB0,pB1,pA0,pA1,t,true,true,true);     WAIT_BAR(2); RESC(); ROT();
    STEP(pA0,pA1,pB0,pB1,t+1,true,true,true);   WAIT_BAR(2); RESC(); ROT();
  }
  #undef CMASK
  #define CMASK(P0,P1,t) do{int jb_=(t)-(NT-4); if(jb_>=0)cmask(P0,P1,jb_,qrel,hi);}while(0)
  #define ENDW(tt) do{ if((tt)+3<NT){WAIT_BAR(2);} else if((tt)+2<NT){WAIT_BAR(1);} else {WAIT_BAR(0);} }while(0)
  for(;t+1<NT;t+=2){
    STEP(pB0,pB1,pA0,pA1,t,(t+3<NT),(t+1<NT),(t+1<NT));       ENDW(t);   RESC(); ROT();
    STEP(pA0,pA1,pB0,pB1,t+1,(t+4<NT),(t+2<NT),(t+2<NT));     ENDW(t+1); RESC(); ROT();
  }
  STEP(pB0,pB1,pA0,pA1,NT-1,false,false,false); RESC();
  { float sacc=pB0[0]+pB0[1]; _Pragma("unroll") for(int r=2;r<16;++r)sacc+=pB0[r]; _Pragma("unroll") for(int r=0;r<16;++r)sacc+=pB1[r]; l_reg+=sacc;
    pw0=(u32x4){PKW(pB0,0),PKW(pB0,2),PKW(pB0,4),PKW(pB0,6)};pw1=(u32x4){PKW(pB0,8),PKW(pB0,10),PKW(pB0,12),PKW(pB0,14)};pw2=(u32x4){PKW(pB1,0),PKW(pB1,2),PKW(pB1,4),PKW(pB1,6)};pw3=(u32x4){PKW(pB1,8),PKW(pB1,10),PKW(pB1,12),PKW(pB1,14)};
    SBAR(); pv(o,vb0+sl_cur,PAF(0),PAF(1),PAF(2),PAF(3)); }
  #undef PKW
  #undef PAF
  #undef VFR
  #undef PIN
  #undef MX3
  #undef GAPA
  #undef GAPB
  #undef EX
  #undef VRD
  #undef KRD
  #undef STEP
  #undef ENDW
  {auto rr=__builtin_amdgcn_permlane32_swap(__float_as_uint(l_reg),__float_as_uint(l_reg),false,false);l_reg=__uint_as_float(rr[0])+__uint_as_float(rr[1]);}
  if(hi==0)wsf[32+r32]=l_reg;asm volatile("s_waitcnt lgkmcnt(0)":::"memory");
  float rli[16];
  #pragma unroll
  for(int r=0;r<16;++r)rli[r]=__builtin_amdgcn_rcpf(wsf[32+crow(r,hi)]);
  bf16*Ow=O+(rowbase+q0+wid*QBLK)*DMO+h*D;
  { bf16*stg=(bf16*)(shm+LDS_OST)+wid*2048;
    #pragma unroll
    for(int r=0;r<16;++r){const int orow=crow(r,hi);
      #pragma unroll
      for(int d0=0;d0<2;++d0)stg[orow*64+d0*32+r32]=__float2bfloat16(o[d0][r]*rli[r]);}
    asm volatile("s_waitcnt lgkmcnt(0)":::"memory");
    #pragma unroll
    for(int i=0;i<4;++i){const int row=i*8+(lane>>3),ch=lane&7; const u32x4 v=*(const u32x4*)(stg+row*64+ch*8); ATTN_STORE16(Ow+(long)row*DMO+ch*8,v);} }
  asm volatile("s_waitcnt lgkmcnt(0)\n\ts_barrier":::"memory");
  #undef DMA_K
  #undef DMA_V
  #undef CMASK
  #undef START
  #undef RESC
  #undef ROT
}
constexpr int ATTN_LDS_BYTES=LDS_BYTES;
struct AttnTensors { const bf16* Q; const bf16* K; const bf16* V; bf16* O; };
struct AttnUnit { int bh; int qb; };
struct StaticOrder {
  int vcu;
  __device__ __forceinline__ explicit StaticOrder(int grid,int block):vcu((grid%8==0)?((block%8)*(grid/8)+block/8):block){}
  __device__ __forceinline__ bool next(int i,AttnUnit&u)const{ if(i>=8)return false; const int s=4*(vcu&1)+(i>>1); u.bh=vcu>>1; u.qb=(i&1)?15-s:s; return true; }
  __device__ __forceinline__ void a_ready(const AttnUnit&)const{}
  __device__ __forceinline__ void done(const AttnUnit&)const{}
};
template<class Sched,int THRL=8> __device__ __forceinline__ void attn_phase(char*lds,const AttnTensors&T,const Sched&S){
  AttnUnit u;
  for(int i=0;S.next(i,u);++i){ S.a_ready(u); attn_unit<THRL>(u.bh/NHEAD,u.bh%NHEAD,u.qb,T.Q,T.K,T.V,T.O,lds); S.done(u); }
}
#undef SBAR
#undef WAIT_BAR
}
namespace {
typedef short bf16x8_t __attribute__((ext_vector_type(8)));
typedef float f32x16_t __attribute__((ext_vector_type(16)));
typedef float f32x4_t __attribute__((ext_vector_type(4)));
typedef float f32x2_t __attribute__((ext_vector_type(2)));

constexpr size_t MiB = 1u << 20;
constexpr size_t WS_CTL = 0, CTL_ZERO_BYTES = 1 * MiB;
constexpr size_t WS_WIN = 1 * MiB;
constexpr size_t WS_WOUT = 6 * MiB;
constexpr size_t WS_WQKV = 8 * MiB;
constexpr size_t WS_CWOUT = 14 * MiB;
constexpr size_t WS_SMALLW = 16 * MiB;
constexpr size_t WS_MISC = 17 * MiB;
constexpr size_t WS_XN = 19 * MiB;
constexpr size_t WS_BIG = 51 * MiB;
constexpr size_t WS_W1T = 147 * MiB;
constexpr size_t WS_W2T = 275 * MiB;
constexpr size_t WS_R3 = 339 * MiB;
constexpr size_t WS_Y = 459 * MiB;
constexpr size_t WS_G = 491 * MiB;
constexpr size_t WS_END = 507 * MiB;
constexpr int CW_MOE0 = 0, CW_MOE1 = 4096, CW_BAR = 8192;
constexpr int MOE_PLAN = 2048;
constexpr int LDS_BYTES = 155648;
constexpr int MISC_OFF = 151552;

#define XB_TMO      128
#define XB_XCNT(j)  (256  + 64 * (j))
#define XB_XSUB(j)  (1280 + 64 * (j))
#define XB_XGEN(j)  (2304 + 64 * (j))
#define XB_TOP      3328
#define XB_TOPGEN   3392
#define XCD_BAR_WORDS 3456
#define XB_SPIN_CAP (1u << 18)

__device__ __forceinline__ unsigned xb_ld(unsigned* p)              { return __hip_atomic_load(p, __ATOMIC_RELAXED, __HIP_MEMORY_SCOPE_AGENT); }
__device__ __forceinline__ unsigned xb_add(unsigned* p, unsigned v) { return __hip_atomic_fetch_add(p, v, __ATOMIC_RELAXED, __HIP_MEMORY_SCOPE_AGENT); }
__device__ __forceinline__ unsigned xb_xcc_id() { return (unsigned)__builtin_amdgcn_s_getreg((3 << 11) | 20) & 0xFu; }
#define XB_SPIN(cond, bar) do { unsigned _sp = 0; while (cond) { __builtin_amdgcn_s_sleep(1); \
    if ((++_sp & 255u) == 0u) { if (xb_ld(&(bar)[XB_TMO])) break; if (_sp > XB_SPIN_CAP) { atomicAdd(&(bar)[XB_TMO], 1u); break; } } } } while (0)

struct XcdBarrier {
    unsigned* bar; unsigned x;
    volatile LAS unsigned* st;
};

__device__ __forceinline__ XcdBarrier xcd_barrier_post(unsigned* bar, volatile LAS unsigned* st) {
    XcdBarrier b; b.bar = bar; b.x = xb_xcc_id(); b.st = st;
    if (threadIdx.x == 0) (void)xb_add(&bar[XB_XCNT(b.x)], 1u);
    return b;
}
__device__ __forceinline__ void xcd_barrier_complete(unsigned* bar, unsigned x, unsigned& nloc, unsigned& nx) {
    const unsigned G = gridDim.x * gridDim.y * gridDim.z;
    unsigned sum, cnt, mine, sp = 0u;
    for (;;) {
        sum = 0u; cnt = 0u; mine = 0u;
#pragma unroll
        for (unsigned j = 0; j < 16; ++j) { const unsigned c = xb_ld(&bar[XB_XCNT(j)]); sum += c; cnt += (c > 0u) ? 1u : 0u; mine = (j == x) ? c : mine; }
        if (sum == G) break;
        __builtin_amdgcn_s_sleep(1);
        if ((++sp & 255u) == 0u) { if (xb_ld(&bar[XB_TMO])) break; if (sp > XB_SPIN_CAP) { atomicAdd(&bar[XB_TMO], 1u); break; } }
    }
    nloc = mine > 0u ? mine : 1u; nx = cnt > 0u ? cnt : 1u;
}

__device__ __forceinline__ void xcd_barrier(const XcdBarrier& b) {
    asm volatile("s_waitcnt vmcnt(0)" ::: "memory");
    __syncthreads();
    if (threadIdx.x == 0) {
        unsigned* bar = b.bar;
        __builtin_amdgcn_s_waitcnt(0);
        unsigned nloc = b.st[0], nx = b.st[1];
        if (nloc == 0u) { xcd_barrier_complete(bar, b.x, nloc, nx); b.st[0] = nloc; b.st[1] = nx; }
        const unsigned old = xb_add(&bar[XB_XSUB(b.x)], 1u);
        const unsigned gen = old / nloc;
        if (old + 1u == (gen + 1u) * nloc) {
            __builtin_amdgcn_fence(__ATOMIC_RELEASE, "agent");
            asm volatile("s_waitcnt vmcnt(0)" ::: "memory");
            const unsigned og = xb_add(&bar[XB_TOP], 1u);
            const unsigned tg = og / nx;
            if (og + 1u == (tg + 1u) * nx) xb_add(&bar[XB_TOPGEN], 1u);
            else XB_SPIN(xb_ld(&bar[XB_TOPGEN]) == tg, bar);
            __builtin_amdgcn_fence(__ATOMIC_ACQUIRE, "agent");
            xb_add(&bar[XB_XGEN(b.x)], 1u);
            asm volatile("s_waitcnt vmcnt(0)" ::: "memory");
        } else {
            XB_SPIN(xb_ld(&bar[XB_XGEN(b.x)]) == gen, bar);
            __builtin_amdgcn_fence(__ATOMIC_ACQUIRE, "agent");
            asm volatile("s_waitcnt vmcnt(0)" ::: "memory");
        }
    }
    __syncthreads();
}


struct Params { const float* in[33]; float* out; unsigned char* ws; int ph_lo, ph_hi; };
struct Frame { LAS unsigned char* lds; int tid, lane, wave, vcu, G; };

template <int CTRL, int RMASK> __device__ __forceinline__ float dpp_f(float x) {
    return __builtin_bit_cast(float, __builtin_amdgcn_update_dpp(0, __builtin_bit_cast(int, x), CTRL, RMASK, 0xf, false));
}
__device__ __forceinline__ float wsum(float x) {
    x += dpp_f<0xB1, 0xf>(x);
    x += dpp_f<0x4E, 0xf>(x);
    x += dpp_f<0x141, 0xf>(x);
    x += dpp_f<0x140, 0xf>(x);
    x += dpp_f<0x142, 0xa>(x);
    x += dpp_f<0x143, 0xc>(x);
    return __builtin_bit_cast(float, __builtin_amdgcn_readlane(__builtin_bit_cast(int, x), 63));
}
__device__ __forceinline__ int crow(int r, int hi) { return (r & 3) + 8 * (r >> 2) + 4 * hi; }
__device__ __forceinline__ float fsigmoid(float x) { return __builtin_amdgcn_rcpf(1.f + __builtin_amdgcn_exp2f(-1.4426950408889634f * x)); }
__device__ __forceinline__ float ftanh(float x) { return 2.f * fsigmoid(2.f * x) - 1.f; }

__device__ __forceinline__ void transpose_item(const float* W, int ldw, bf16_t* WT, int ldt, int k0, int n0, int drow0, LAS float* scr, int lane) {
#pragma unroll 8
    for (int i = 0; i < 32; ++i) { const int kk = 2 * i + (lane >> 5); scr[kk * 33 + (lane & 31)] = W[(size_t)(k0 + kk) * ldw + n0 + (lane & 31)]; }
    asm volatile("s_waitcnt lgkmcnt(0)" ::: "memory");
    const int c = lane & 7;
#pragma unroll
    for (int j = 0; j < 4; ++j) { const int n = (lane >> 3) + 8 * j; const LAS float* s = scr + (8 * c) * 33 + n;
        u32x4_t o; o.x = pk2(s[0 * 33], s[1 * 33]); o.y = pk2(s[2 * 33], s[3 * 33]); o.z = pk2(s[4 * 33], s[5 * 33]); o.w = pk2(s[6 * 33], s[7 * 33]);
        *(u32x4_t*)(WT + (size_t)(drow0 + n) * ldt + k0 + 8 * c) = o; }
    asm volatile("s_waitcnt lgkmcnt(0)" ::: "memory");
}
constexpr int IT_IN = 16 * 72, IT_OUT = 16 * 32, IT_QKV = 16 * 96, IT_DENSE = IT_IN + 2 * IT_OUT + IT_QKV;
constexpr int IT_GU = 16 * 16, IT_DN = 8 * 32, IT_EXP = 2 * IT_GU + IT_DN;
__device__ __forceinline__ void conv_dense_item(const Params& P, int it, LAS float* scr, int lane) {
    unsigned char* ws = P.ws;
    if (it < IT_IN) { const int kb = it / 72, nb = it % 72; transpose_item(P.in[4], INW, (bf16_t*)(ws + WS_WIN), D, kb * 64, nb * 32, nb * 32, scr, lane); return; } it -= IT_IN;
    if (it < IT_OUT) { const int kb = it / 32, nb = it % 32; transpose_item(P.in[18], D, (bf16_t*)(ws + WS_WOUT), D, kb * 64, nb * 32, nb * 32, scr, lane); return; } it -= IT_OUT;
    if (it < IT_QKV) { const int kb = it / 96, nb = it % 96; transpose_item(P.in[19], QKVW, (bf16_t*)(ws + WS_WQKV), D, kb * 64, nb * 32, nb * 32, scr, lane); return; } it -= IT_QKV;
    { const int kb = it / 32, nb = it % 32; transpose_item(P.in[25], D, (bf16_t*)(ws + WS_CWOUT), D, kb * 64, nb * 32, nb * 32, scr, lane); }
}
__device__ __forceinline__ void conv_moe_item(const Params& P, int it, LAS float* scr, int lane) {
    const int le = it / IT_EXP; int r = it % IT_EXP;
    if (r < 2 * IT_GU) {
        const int isup = r / IT_GU; r %= IT_GU; const int kb = r / 16, nb = r % 16, n0 = nb * 32;
        const float* W = (isup ? P.in[31] : P.in[30]) + (size_t)le * D * MH;
        transpose_item(W, MH, (bf16_t*)(P.ws + WS_W1T) + (size_t)le * 1024 * D, D, kb * 64, n0, (n0 / 128) * 256 + isup * 128 + (n0 % 128), scr, lane);
    } else {
        r -= 2 * IT_GU; const int kb = r / 32, nb = r % 32;
        transpose_item(P.in[32] + (size_t)le * MH * D, D, (bf16_t*)(P.ws + WS_W2T) + (size_t)le * D * MH, MH, kb * 64, nb * 32, nb * 32, scr, lane);
    }
}
__device__ __forceinline__ void rms_row_to_bf16(const float* xrow, const float* g, bf16_t* orow, int lane) {
    const f32x4_t* xr = (const f32x4_t*)xrow + lane; const f32x4_t* gr = (const f32x4_t*)g + lane;
    f32x4_t v[4]; float s = 0.f;
#pragma unroll
    for (int j = 0; j < 4; ++j) { v[j] = xr[64 * j]; s += (v[j].x * v[j].x + v[j].y * v[j].y) + (v[j].z * v[j].z + v[j].w * v[j].w); }
    const float rs = rsqrtf(wsum(s) * (1.f / D) + 1e-6f);
    u32x2_t* o8 = (u32x2_t*)orow + lane;
#pragma unroll
    for (int j = 0; j < 4; ++j) { const f32x4_t gg = gr[64 * j]; u32x2_t o; o.x = pk2(v[j].x * rs * gg.x, v[j].y * rs * gg.y); o.y = pk2(v[j].z * rs * gg.z, v[j].w * rs * gg.w); o8[64 * j] = o; }
}

__device__ __forceinline__ void ph_prologue(const Frame& F, const Params& P) {
    LAS float* scr = (LAS float*)(F.lds + F.wave * 16384);
    const int gw = F.vcu * 8 + F.wave, NGW = F.G * 8;
    for (int it = gw; it < IT_DENSE; it += NGW) conv_dense_item(P, it, scr, F.lane);
    bf16_t* w2p = (bf16_t*)(P.ws + WS_SMALLW); bf16_t* a2p = w2p + 32768; bf16_t* g2p = a2p + 32768; bf16_t* wpp = g2p + 65536; float* cs = (float*)(wpp + 65536);
    const int gt = F.vcu * 512 + F.tid, NGT = F.G * 512;
    for (int idx = gt; idx < 32768; idx += NGT) {
        const int row = idx >> 6, k = idx & 63, hd = row >> 6, nt = (row >> 5) & 1, c = row & 31, col = hd * 64 + 2 * c + nt;
        w2p[idx] = (bf16_t)f2bf(P.in[7][k * RW + col]); a2p[idx] = (bf16_t)f2bf(P.in[9][k * RW + col]);
    }
    for (int idx = gt; idx < 65536; idx += NGT) {
        { const int row = idx >> 7, k = idx & 127, hd = row >> 6, nt = (row >> 5) & 1, c = row & 31, col = hd * 64 + 2 * c + nt; g2p[idx] = (bf16_t)f2bf(P.in[10][k * RW + col]); }
        { const int gi = idx >> 14, row = (idx >> 7) & 127, k = idx & 127, nh = row >> 6, nt = (row >> 5) & 1, c = row & 31, n = nh * 64 + 2 * c + nt;
          wpp[idx] = (bf16_t)f2bf(P.in[16][(size_t)gi * 16384 + k * 128 + n]); }
    }
    for (int i = gt; i < SEQ * 8; i += NGT) {
        const int t = i >> 3, f = i & 7;
        const double inv = exp(-log(500000.0) * (double)f / 8.0), ang = (double)t * inv;
        cs[i * 2] = (float)cos(ang); cs[i * 2 + 1] = (float)sin(ang);
    }
    for (int m = gw; m < NTOK; m += NGW) rms_row_to_bf16(P.in[0] + (size_t)m * D, P.in[1], (bf16_t*)(P.ws + WS_XN) + (size_t)m * D, F.lane);
}

__device__ __forceinline__ void ph_prep(const Frame& F, const Params& P) {
    const bf16_t* p = (const bf16_t*)(P.ws + WS_BIG);
    const float* mu = P.in[5]; const float* w0 = P.in[6]; const float* a0 = P.in[8]; const float* k_k = P.in[11]; const float* k_a = P.in[12]; const float* pool_scale = P.in[17];
    const bf16_t* w2p = (const bf16_t*)(P.ws + WS_SMALLW); const bf16_t* a2p = w2p + 32768; const bf16_t* g2p = a2p + 32768; const bf16_t* wpp = g2p + 65536;
    float* Wd = (float*)(P.ws + WS_R3);
    bf16_t* Rb = (bf16_t*)(P.ws + WS_R3 + 32 * MiB); bf16_t* Kb = Rb + (size_t)NTOK * RW; bf16_t* KKb = Kb + (size_t)NTOK * RW; bf16_t* Bb = KKb + (size_t)NTOK * RW; bf16_t* Vb = Bb + (size_t)NTOK * RW;
    bf16_t* Gb = (bf16_t*)(P.ws + WS_G); bf16_t* XN = (bf16_t*)(P.ws + WS_XN);
    LAS unsigned char* lora = F.lds; LAS unsigned char* poold = F.lds + 32 * 528;
    const int tid = F.tid, lane = F.lane, r32 = lane & 31, hi = lane >> 5, hd = F.wave;
    for (int unit = F.vcu; unit < NTOK / 32; unit += F.G) {
        const int tok0 = unit * 32, t0 = tok0 % SEQ;
        {
            const int tl = tid >> 4, c0 = (tid & 15) * 16, t = t0 + tl;
            const bf16_t* pc = p + (size_t)(tok0 + tl) * INW + 1536 + c0;
            u32x4_t cu[2], pv[2];
            cu[0] = *(const u32x4_t*)pc; cu[1] = *(const u32x4_t*)(pc + 8);
            if (t > 0) { pv[0] = *(const u32x4_t*)(pc - INW); pv[1] = *(const u32x4_t*)(pc - INW + 8); } else { pv[0] = (u32x4_t){0, 0, 0, 0}; pv[1] = pv[0]; }
            u32x4_t ov[2];
#pragma unroll
            for (int h2 = 0; h2 < 2; ++h2) {
#pragma unroll
                for (int q = 0; q < 4; ++q) {
                    const f32x2_t m2 = *(const f32x2_t*)(mu + 1536 + c0 + h2 * 8 + q * 2);
                    const float c_lo = bflo(cu[h2][q]), c_hi = bfhi(cu[h2][q]), p_lo = bflo(pv[h2][q]), p_hi = bfhi(pv[h2][q]);
                    float z0 = c_lo + (p_lo - c_lo) * m2.x, z1 = c_hi + (p_hi - c_hi) * m2.y;
                    if (c0 < 64) { z0 = ftanh(z0); z1 = ftanh(z1); } else if (c0 >= 128) { z0 = fsigmoid(z0); z1 = fsigmoid(z1); }
                    ov[h2][q] = pk2(z0, z1);
                }
            }
            *(LAS u32x4_t*)(lora + tl * 528 + c0 * 2) = ov[0]; *(LAS u32x4_t*)(lora + tl * 528 + c0 * 2 + 16) = ov[1];
        }
        {
            const int c = tid, gi = c >> 7, win = 2 << gi;
            const bf16_t* pu = p + (size_t)tok0 * INW + SHIFTW + c;
            float s = 0.f;
            for (int q = 1; q < win; ++q) if (t0 - q >= 0) s += bf2f(pu[-(ptrdiff_t)q * INW]);
            for (int tl = 0; tl < 32; ++tl) {
                const int t = t0 + tl; const float u = bf2f(pu[(ptrdiff_t)tl * INW]);
                s += u;
                const int cnt = (t + 1 < win) ? (t + 1) : win;
                *(LAS bf16_t*)(poold + tl * 1040 + c * 2) = (bf16_t)f2bf(s / (float)cnt - u);
                if (t - win + 1 >= 0) s -= bf2f(pu[(ptrdiff_t)(tl - win + 1) * INW]);
            }
        }
        __syncthreads();
        const int ch = hd * 64 + 2 * r32;
        const LAS unsigned char* arow = lora + r32 * 528 + hi * 16;
        {
            f32x16_t acc0 = {}, acc1 = {};
#pragma unroll
            for (int ks = 0; ks < 8; ++ks) {
                const bf16x8_t a = *(const LAS bf16x8_t*)(arow + (128 + ks * 16) * 2);
                const bf16x8_t b0 = *(const bf16x8_t*)(g2p + (size_t)(hd * 64 + r32) * 128 + ks * 16 + hi * 8);
                const bf16x8_t b1 = *(const bf16x8_t*)(g2p + (size_t)(hd * 64 + 32 + r32) * 128 + ks * 16 + hi * 8);
                acc0 = __builtin_amdgcn_mfma_f32_32x32x16_bf16(a, b0, acc0, 0, 0, 0); acc1 = __builtin_amdgcn_mfma_f32_32x32x16_bf16(a, b1, acc1, 0, 0, 0);
            }
#pragma unroll
            for (int r = 0; r < 16; ++r) *(unsigned*)(Gb + (size_t)(tok0 + crow(r, hi)) * RW + ch) = pk2(acc0[r], acc1[r]);
        }
        {
            f32x16_t acc0 = {}, acc1 = {};
#pragma unroll
            for (int ks = 0; ks < 4; ++ks) {
                const bf16x8_t a = *(const LAS bf16x8_t*)(arow + (ks * 16) * 2);
                const bf16x8_t b0 = *(const bf16x8_t*)(w2p + (size_t)(hd * 64 + r32) * 64 + ks * 16 + hi * 8);
                const bf16x8_t b1 = *(const bf16x8_t*)(w2p + (size_t)(hd * 64 + 32 + r32) * 64 + ks * 16 + hi * 8);
                acc0 = __builtin_amdgcn_mfma_f32_32x32x16_bf16(a, b0, acc0, 0, 0, 0); acc1 = __builtin_amdgcn_mfma_f32_32x32x16_bf16(a, b1, acc1, 0, 0, 0);
            }
            const f32x2_t w0p = *(const f32x2_t*)(w0 + ch);
#pragma unroll
            for (int r = 0; r < 16; ++r) {
                f32x2_t dv;
                dv.x = -0.6065306597126334f * fsigmoid(w0p.x + acc0[r]);
                dv.y = -0.6065306597126334f * fsigmoid(w0p.y + acc1[r]);
                *(f32x2_t*)(Wd + (size_t)(tok0 + crow(r, hi)) * RW + ch) = dv;
            }
        }
        {
            f32x16_t acc0 = {}, acc1 = {};
#pragma unroll
            for (int ks = 0; ks < 4; ++ks) {
                const bf16x8_t a = *(const LAS bf16x8_t*)(arow + (64 + ks * 16) * 2);
                const bf16x8_t b0 = *(const bf16x8_t*)(a2p + (size_t)(hd * 64 + r32) * 64 + ks * 16 + hi * 8);
                const bf16x8_t b1 = *(const bf16x8_t*)(a2p + (size_t)(hd * 64 + 32 + r32) * 64 + ks * 16 + hi * 8);
                acc0 = __builtin_amdgcn_mfma_f32_32x32x16_bf16(a, b0, acc0, 0, 0, 0); acc1 = __builtin_amdgcn_mfma_f32_32x32x16_bf16(a, b1, acc1, 0, 0, 0);
            }
            const f32x2_t a0p = *(const f32x2_t*)(a0 + ch), kkp = *(const f32x2_t*)(k_k + ch), kap = *(const f32x2_t*)(k_a + ch);
            const f32x2_t mur = *(const f32x2_t*)(mu + ch), muk = *(const f32x2_t*)(mu + 512 + ch), muv = *(const f32x2_t*)(mu + 1024 + ch);
#pragma unroll
            for (int r = 0; r < 16; ++r) {
                const int row = crow(r, hi), t = t0 + row; const size_t tok = (size_t)(tok0 + row);
                const bf16_t* pc = p + tok * INW + ch;
                const unsigned cr = *(const unsigned*)pc, ck = *(const unsigned*)(pc + 512), cv = *(const unsigned*)(pc + 1024);
                unsigned qr = 0, qk = 0, qv = 0;
                if (t > 0) { qr = *(const unsigned*)(pc - INW); qk = *(const unsigned*)(pc - INW + 512); qv = *(const unsigned*)(pc - INW + 1024); }
                const float r0 = bflo(cr) + (bflo(qr) - bflo(cr)) * mur.x, r1 = bfhi(cr) + (bfhi(qr) - bfhi(cr)) * mur.y;
                const float k0 = bflo(ck) + (bflo(qk) - bflo(ck)) * muk.x, k1 = bfhi(ck) + (bfhi(qk) - bfhi(ck)) * muk.y;
                const float v0 = bflo(cv) + (bflo(qv) - bflo(cv)) * muv.x, v1 = bfhi(cv) + (bfhi(qv) - bfhi(cv)) * muv.y;
                const float av0 = fsigmoid(a0p.x + acc0[r]), av1 = fsigmoid(a0p.y + acc1[r]);
                float kk0 = k0 * kkp.x, kk1 = k1 * kkp.y;
                float ss = kk0 * kk0 + kk1 * kk1;
#pragma unroll
                for (int o = 1; o < 32; o <<= 1) ss += __shfl_xor(ss, o);
                const float inv = 1.f / fmaxf(sqrtf(ss), 1e-12f);
                kk0 *= inv; kk1 *= inv;
                const size_t o = tok * RW + ch;
                *(unsigned*)(Rb + o) = pk2(r0, r1);
                *(unsigned*)(Kb + o) = pk2(k0 * (1.f + (av0 - 1.f) * kap.x), k1 * (1.f + (av1 - 1.f) * kap.y));
                *(unsigned*)(Vb + o) = pk2(v0, v1);
                *(unsigned*)(KKb + o) = pk2(kk0, kk1);
                *(unsigned*)(Bb + o) = pk2(kk0 * av0, kk1 * av1);
            }
        }
        {
            const int gi = F.wave >> 1, nh = F.wave & 1;
            const LAS unsigned char* prow = poold + r32 * 1040 + (gi * 128 + hi * 8) * 2;
            f32x16_t acc0 = {}, acc1 = {};
#pragma unroll
            for (int ks = 0; ks < 8; ++ks) {
                const bf16x8_t a = *(const LAS bf16x8_t*)(prow + ks * 32);
                const bf16x8_t b0 = *(const bf16x8_t*)(wpp + (size_t)(gi * 128 + nh * 64 + r32) * 128 + ks * 16 + hi * 8);
                const bf16x8_t b1 = *(const bf16x8_t*)(wpp + (size_t)(gi * 128 + nh * 64 + 32 + r32) * 128 + ks * 16 + hi * 8);
                acc0 = __builtin_amdgcn_mfma_f32_32x32x16_bf16(a, b0, acc0, 0, 0, 0); acc1 = __builtin_amdgcn_mfma_f32_32x32x16_bf16(a, b1, acc1, 0, 0, 0);
            }
            const int n = gi * 128 + nh * 64 + 2 * r32;
            const f32x2_t ps = *(const f32x2_t*)(pool_scale + n);
#pragma unroll
            for (int r = 0; r < 16; ++r) *(unsigned*)(XN + (size_t)(tok0 + crow(r, hi)) * D + RW + n) = pk2(acc0[r] * ps.x, acc1[r] * ps.y);
        }
        __syncthreads();
    }
}

constexpr int CB = 9216, CRS = 144;
constexpr size_t CH_UNIT_BYTES = 49152;
__device__ __forceinline__ f32x16_t tile_mm(const LAS unsigned char* A, int r0, const LAS unsigned char* Bt, int c0, f32x16_t acc, int r32, int hi) {
#pragma unroll
    for (int ks = 0; ks < 4; ++ks) {
        const bf16x8_t a = *(const LAS bf16x8_t*)(A + (r0 + r32) * CRS + ks * 32 + hi * 16);
        const bf16x8_t b = *(const LAS bf16x8_t*)(Bt + (c0 + r32) * CRS + ks * 32 + hi * 16);
        acc = __builtin_amdgcn_mfma_f32_32x32x16_bf16(a, b, acc, 0, 0, 0);
    }
    return acc;
}
__device__ __forceinline__ void put_rm(LAS unsigned char* buf, const f32x16_t& v, int r0, int c0, int r32, int hi) {
#pragma unroll
    for (int r = 0; r < 16; ++r) *(LAS bf16_t*)(buf + (r0 + crow(r, hi)) * CRS + (c0 + r32) * 2) = (bf16_t)f2bf(v[r]);
}
__device__ __forceinline__ void put_tr(LAS unsigned char* buf, const f32x16_t& v, int r0, int c0, int r32, int hi, float sgn) {
#pragma unroll
    for (int g = 0; g < 4; ++g) { u32x2_t w; w.x = pk2(sgn * v[4 * g], sgn * v[4 * g + 1]); w.y = pk2(sgn * v[4 * g + 2], sgn * v[4 * g + 3]);
        *(LAS u32x2_t*)(buf + (c0 + r32) * CRS + (r0 + 8 * g + 4 * hi) * 2) = w; }
}
__device__ __forceinline__ void ph_chunkA(const Frame& F, const Params& P) {
    const float* Lw = (const float*)(P.ws + WS_R3);
    const bf16_t* Rb = (const bf16_t*)(P.ws + WS_R3 + 32 * MiB); const bf16_t* Kb = Rb + (size_t)NTOK * RW; const bf16_t* KKb = Kb + (size_t)NTOK * RW; const bf16_t* Bb = KKb + (size_t)NTOK * RW; const bf16_t* Vb = Bb + (size_t)NTOK * RW;
    const int tid = F.tid, lane = F.lane, r32 = lane & 31, hi = lane >> 5, wave = F.wave;
    LAS unsigned char* L = F.lds;
#define SL(n) (L + (n) * CB)
    LAS unsigned char* s_khat = SL(0); LAS unsigned char* s_bhat = SL(1); LAS unsigned char* s_ktil = SL(2); LAS unsigned char* s_rtil = SL(3); LAS unsigned char* s_kbar = SL(4);
    LAS unsigned char* s_ktilT = SL(5); LAS unsigned char* s_bbarT = SL(6); LAS unsigned char* s_VT = SL(7); LAS unsigned char* s_Akk = SL(8); LAS unsigned char* s_AbrT = SL(9);
    LAS unsigned char* s_nTAbrT = SL(13); LAS unsigned char* s_nTBbT = SL(14);
    LAS unsigned char* s_QyT = SL(6); LAS unsigned char* s_QsT = SL(9);
    LAS float* cum = (LAS float*)SL(10);
    LAS float* WCb = (LAS float*)SL(15);
#define PB(b) ((b) ? SL(0) : SL(10))
#define PTB(b) ((b) ? SL(1) : SL(11))
#define TB(b) ((b) ? SL(2) : SL(12))
    const int tw = wave & 3, rt = (tw >> 1) * 32, ct = (tw & 1) * 32;
#pragma unroll 1
    for (int unit = F.vcu; unit < 2048; unit += F.G) {
        const int bh = unit >> 6, c = unit & 63, bb = bh >> 3, hd = bh & 7;
        const size_t gbase = ((size_t)bb * SEQ + (size_t)c * 64) * RW + hd * 64;
        unsigned char* outp = P.ws + WS_BIG + (size_t)unit * CH_UNIT_BYTES;
        bf16_t* PsTp = (bf16_t*)outp; bf16_t* PyT = (bf16_t*)(outp + 8192); float* VQsT = (float*)(outp + 16384); float* VQyT = (float*)(outp + 32768);
        const int t = tid >> 3, j0 = (tid & 7) * 8;
        const size_t off = gbase + (size_t)t * RW + j0;
        const f32x4_t l0 = *(const f32x4_t*)(Lw + off), l1 = *(const f32x4_t*)(Lw + off + 4);
        const u32x4_t rr = *(const u32x4_t*)(Rb + off), kr = *(const u32x4_t*)(Kb + off), kkr = *(const u32x4_t*)(KKb + off), br = *(const u32x4_t*)(Bb + off), vr = *(const u32x4_t*)(Vb + off);
        *(LAS f32x4_t*)(cum + t * 68 + j0) = l0; *(LAS f32x4_t*)(cum + t * 68 + j0 + 4) = l1;
        __syncthreads();
        if (tid < 64) { float run = 0.f;
#pragma unroll
            for (int q = 0; q < 64; ++q) { run += cum[q * 68 + tid]; cum[q * 68 + tid] = run; } }
        __syncthreads();
        {
            const f32x4_t c0v = *(const LAS f32x4_t*)(cum + t * 68 + j0), c1v = *(const LAS f32x4_t*)(cum + t * 68 + j0 + 4);
            const f32x4_t e0v = *(const LAS f32x4_t*)(cum + 63 * 68 + j0), e1v = *(const LAS f32x4_t*)(cum + 63 * 68 + j0 + 4);
            u32x4_t o_khat, o_bhat, o_ktil, o_rtil, o_kbar;
#pragma unroll
            for (int e2 = 0; e2 < 4; ++e2) {
                float res[2][8];
#pragma unroll
                for (int q = 0; q < 2; ++q) {
                    const int e = 2 * e2 + q;
                    const float cu = e < 4 ? c0v[e & 3] : c1v[e & 3], lw = e < 4 ? l0[e & 3] : l1[e & 3], ce = e < 4 ? e0v[e & 3] : e1v[e & 3];
                    const float Wt = __builtin_amdgcn_exp2f(1.4426950408889634f * cu), Wp = __builtin_amdgcn_exp2f(1.4426950408889634f * (cu - lw));
                    const float iW = __builtin_amdgcn_exp2f(-1.4426950408889634f * cu), WCr = __builtin_amdgcn_exp2f(1.4426950408889634f * (ce - cu));
                    const float rv = q ? bfhi(rr[e2]) : bflo(rr[e2]), kv = q ? bfhi(kr[e2]) : bflo(kr[e2]), kkv = q ? bfhi(kkr[e2]) : bflo(kkr[e2]);
                    const float bv = q ? bfhi(br[e2]) : bflo(br[e2]);
                    res[q][0] = kv * iW; res[q][1] = bv * iW; res[q][2] = kkv * Wp; res[q][3] = rv * Wt; res[q][4] = kv * WCr; res[q][5] = bv * WCr;
                    if (t == 63) WCb[j0 + e] = __builtin_amdgcn_exp2f(1.4426950408889634f * ce);
                    *(LAS bf16_t*)(s_ktilT + (j0 + e) * CRS + t * 2) = (bf16_t)f2bf(res[q][2]);
                    *(LAS bf16_t*)(s_bbarT + (j0 + e) * CRS + t * 2) = (bf16_t)f2bf(res[q][5]);
                    *(LAS bf16_t*)(s_VT + (j0 + e) * CRS + t * 2) = (bf16_t)((q ? (vr[e2] >> 16) : (vr[e2] & 0xffffu)));
                }
                o_khat[e2] = pk2(res[0][0], res[1][0]); o_bhat[e2] = pk2(res[0][1], res[1][1]); o_ktil[e2] = pk2(res[0][2], res[1][2]);
                o_rtil[e2] = pk2(res[0][3], res[1][3]); o_kbar[e2] = pk2(res[0][4], res[1][4]);
            }
            *(LAS u32x4_t*)(s_khat + t * CRS + j0 * 2) = o_khat; *(LAS u32x4_t*)(s_bhat + t * CRS + j0 * 2) = o_bhat; *(LAS u32x4_t*)(s_ktil + t * CRS + j0 * 2) = o_ktil;
            *(LAS u32x4_t*)(s_rtil + t * CRS + j0 * 2) = o_rtil; *(LAS u32x4_t*)(s_kbar + t * CRS + j0 * 2) = o_kbar;
        }
        __syncthreads();
        const f32x16_t zero16 = {};
        f32x16_t Nt = tile_mm(s_bhat, rt, s_ktil, ct, zero16, r32, hi);
#pragma unroll
        for (int r = 0; r < 16; ++r) if (!(rt + crow(r, hi) < ct + r32)) Nt[r] = 0.f;
        f32x16_t keep = zero16;
        if (wave < 4) {
            f32x16_t a = tile_mm(s_khat, rt, s_ktil, ct, zero16, r32, hi);
#pragma unroll
            for (int r = 0; r < 16; ++r) if (!(rt + crow(r, hi) < ct + r32)) a[r] = 0.f;
            put_rm(s_Akk, a, rt, ct, r32, hi);
            keep = tile_mm(s_khat, rt, s_rtil, ct, zero16, r32, hi);
#pragma unroll
            for (int r = 0; r < 16; ++r) if (!(rt + crow(r, hi) <= ct + r32)) keep[r] = 0.f;
        } else {
            f32x16_t a = tile_mm(s_bhat, rt, s_rtil, ct, zero16, r32, hi);
#pragma unroll
            for (int r = 0; r < 16; ++r) if (!(rt + crow(r, hi) <= ct + r32)) a[r] = 0.f;
            put_tr(s_AbrT, a, rt, ct, r32, hi, 1.f);
        }
        f32x16_t M = Nt;
        if (wave < 4) {
#pragma unroll
            for (int r = 0; r < 16; ++r) M[r] = ((rt + crow(r, hi) == ct + r32) ? 1.f : 0.f) - Nt[r];
        }
        __syncthreads();
        if (wave < 4) put_rm(TB(0), M, rt, ct, r32, hi);
        else { put_rm(PB(0), M, rt, ct, r32, hi); put_tr(PTB(0), M, rt, ct, r32, hi, 1.f); }
        __syncthreads();
#pragma unroll
        for (int it = 0; it < 6; ++it) {
            const int cb = it & 1, nb = cb ^ 1;
            if (wave < 4) {
                if (it > 0) M = tile_mm(TB(cb ^ 1 ^ 1), rt, PTB(cb), ct, M, r32, hi);
                put_rm(TB(nb), M, rt, ct, r32, hi);
            } else if (it < 5) {
                M = tile_mm(PB(cb), rt, PTB(cb), ct, zero16, r32, hi);
                put_rm(PB(nb), M, rt, ct, r32, hi); put_tr(PTB(nb), M, rt, ct, r32, hi, 1.f);
            }
            __syncthreads();
        }
        {
            f32x16_t a = tile_mm(TB(0), rt, (wave < 4) ? s_AbrT : s_bbarT, ct, zero16, r32, hi);
            put_tr((wave < 4) ? s_nTAbrT : s_nTBbT, a, rt, ct, r32, hi, -1.f);
        }
        __syncthreads();
        if (wave < 4) {
            f32x16_t qy = tile_mm(s_Akk, rt, s_nTAbrT, ct, keep, r32, hi);
            f32x16_t cpy;
#pragma unroll
            for (int g = 0; g < 4; ++g) { const u32x2_t w = *(const LAS u32x2_t*)(s_rtil + (ct + r32) * CRS + (rt + 8 * g + 4 * hi) * 2);
                cpy[4 * g] = bflo(w.x); cpy[4 * g + 1] = bfhi(w.x); cpy[4 * g + 2] = bflo(w.y); cpy[4 * g + 3] = bfhi(w.y); }
            f32x16_t py = tile_mm(s_ktilT, rt, s_nTAbrT, ct, cpy, r32, hi);
#pragma unroll
            for (int g = 0; g < 4; ++g) { u32x2_t w; w.x = pk2(py[4 * g], py[4 * g + 1]); w.y = pk2(py[4 * g + 2], py[4 * g + 3]);
                *(u32x2_t*)(PyT + (size_t)(ct + r32) * 64 + rt + 8 * g + 4 * hi) = w; }
            __syncthreads();
            put_tr(s_QyT, qy, rt, ct, r32, hi, 1.f);
        } else {
            f32x16_t cq;
#pragma unroll
            for (int r = 0; r < 16; ++r) cq[r] = bf2f(*(const LAS bf16_t*)(s_kbar + (rt + crow(r, hi)) * CRS + (ct + r32) * 2));
            f32x16_t qs = tile_mm(s_Akk, rt, s_nTBbT, ct, cq, r32, hi);
            f32x16_t cps;
#pragma unroll
            for (int r = 0; r < 16; ++r) cps[r] = (rt + crow(r, hi) == ct + r32) ? WCb[ct + r32] : 0.f;
            f32x16_t ps = tile_mm(s_ktilT, rt, s_nTBbT, ct, cps, r32, hi);
#pragma unroll
            for (int g = 0; g < 4; ++g) { u32x2_t w; w.x = pk2(ps[4 * g], ps[4 * g + 1]); w.y = pk2(ps[4 * g + 2], ps[4 * g + 3]);
                *(u32x2_t*)(PsTp + (size_t)(ct + r32) * 64 + rt + 16 * (g >> 1) + 8 * hi + 4 * (g & 1)) = w; }
            __syncthreads();
            put_tr(s_QsT, qs, rt, ct, r32, hi, 1.f);
        }
        __syncthreads();
        {
            f32x16_t a = tile_mm((wave < 4) ? s_QyT : s_QsT, rt, s_VT, ct, zero16, r32, hi);
            if (wave < 4) {
#pragma unroll
                for (int r = 0; r < 16; ++r) VQyT[(size_t)(rt + crow(r, hi)) * 64 + ct + r32] = a[r];
            } else {
                u32x4_t w0, w1;
                w0.x = pk2(a[0], a[1]); w0.y = pk2(a[2], a[3]); w0.z = pk2(a[4], a[5]); w0.w = pk2(a[6], a[7]);
                w1.x = pk2(a[8], a[9]); w1.y = pk2(a[10], a[11]); w1.z = pk2(a[12], a[13]); w1.w = pk2(a[14], a[15]);
                u32x4_t* dq = (u32x4_t*)((unsigned char*)VQsT + (size_t)(tw * 64 + lane) * 32); dq[0] = w0; dq[1] = w1;
            }
        }
        __syncthreads();
    }
#undef SL
#undef PB
#undef PTB
#undef TB
}
constexpr int CHB_SLOT = 17408;
constexpr int CHB_NSLOT = 7;
constexpr int CHB_SOUT = CHB_NSLOT * CHB_SLOT;
__device__ __forceinline__ void ph_chunkB(const Frame& F, const Params& P) {
    const int lane = F.lane, r32 = lane & 31, hi = lane >> 5, wave = F.wave;
    if (F.vcu >= 32) {
        LAS float* scr = (LAS float*)(F.lds + F.wave * 16384);
        const int cw = (F.vcu - 32) * 8 + wave, NCW = (F.G - 32) * 8;
        for (int itx = cw; itx < 64 * IT_EXP; itx += NCW) conv_moe_item(P, itx, scr, lane);
        return;
    }
    const int bh = F.vcu;
    bf16_t* Sst = (bf16_t*)(P.ws + WS_Y) + (size_t)bh * 64 * 4096;
    const unsigned char* ub = P.ws + WS_BIG + (size_t)bh * 64 * CH_UNIT_BYTES;
    LAS unsigned char* L = F.lds;
    const int lw = wave - 2;
    u32x4_t ld[16];
#define CHB_GLOAD(c_) do { const unsigned char* up_ = ub + (size_t)(c_) * CH_UNIT_BYTES; \
        _Pragma("unroll") for (int q = 0; q < 8; ++q) ld[q] = *(const u32x4_t*)(up_ + (q * 64 + lane) * 16); \
        _Pragma("unroll") for (int q = 0; q < 8; ++q) ld[8 + q] = *(const u32x4_t*)(up_ + 16384 + (q * 64 + lane) * 16); } while (0)
#define CHB_LWRITE(slot_) do { LAS unsigned char* sl_ = L + (slot_) * CHB_SLOT; \
        _Pragma("unroll") for (int q = 0; q < 8; ++q) { const int p_ = q * 64 + lane; *(LAS u32x4_t*)(sl_ + (p_ >> 3) * CRS + (p_ & 7) * 16) = ld[q]; } \
        _Pragma("unroll") for (int q = 0; q < 8; ++q) *(LAS u32x4_t*)(sl_ + 9216 + (q * 64 + lane) * 16) = ld[8 + q]; } while (0)
    if (wave >= 2) { CHB_GLOAD(lw); CHB_LWRITE(lw); CHB_GLOAD(lw + 6); }
    f32x16_t X0 = {}, X1 = {};
    const int it = (wave & 1) * 32;
    int turn = 0, slot = 0;
#pragma unroll 1
    for (int c = 0; c < 64; ++c) {
        asm volatile("s_waitcnt lgkmcnt(0)" ::: "memory"); __builtin_amdgcn_s_barrier(); asm volatile("" ::: "memory");
        if (wave < 2) {
            const LAS unsigned char* sl = L + slot * CHB_SLOT;
            LAS unsigned char* so = L + CHB_SOUT + (c & 1) * CB;
            bf16x8_t xb[4];
#pragma unroll
            for (int s2 = 0; s2 < 2; ++s2) {
                u32x4_t w0, w1;
                w0.x = pk2(X0[8 * s2], X0[8 * s2 + 1]); w0.y = pk2(X0[8 * s2 + 2], X0[8 * s2 + 3]); w0.z = pk2(X0[8 * s2 + 4], X0[8 * s2 + 5]); w0.w = pk2(X0[8 * s2 + 6], X0[8 * s2 + 7]);
                w1.x = pk2(X1[8 * s2], X1[8 * s2 + 1]); w1.y = pk2(X1[8 * s2 + 2], X1[8 * s2 + 3]); w1.z = pk2(X1[8 * s2 + 4], X1[8 * s2 + 5]); w1.w = pk2(X1[8 * s2 + 6], X1[8 * s2 + 7]);
                xb[s2] = __builtin_bit_cast(bf16x8_t, w0); xb[2 + s2] = __builtin_bit_cast(bf16x8_t, w1);
                LAS unsigned char* row = so + (it + r32) * CRS;
                *(LAS u32x2_t*)(row + (16 * s2 + 4 * hi) * 2) = (u32x2_t){w0.x, w0.y}; *(LAS u32x2_t*)(row + (16 * s2 + 8 + 4 * hi) * 2) = (u32x2_t){w0.z, w0.w};
                *(LAS u32x2_t*)(row + (32 + 16 * s2 + 4 * hi) * 2) = (u32x2_t){w1.x, w1.y}; *(LAS u32x2_t*)(row + (32 + 16 * s2 + 8 + 4 * hi) * 2) = (u32x2_t){w1.z, w1.w};
            }
            f32x16_t Y0, Y1;
            {
                const LAS u32x4_t* f0 = (const LAS u32x4_t*)(sl + 9216 + ((0 * 2 + (wave & 1)) * 64 + lane) * 32);
                const LAS u32x4_t* f1 = (const LAS u32x4_t*)(sl + 9216 + ((1 * 2 + (wave & 1)) * 64 + lane) * 32);
                const u32x4_t a0 = f0[0], a1 = f0[1], b0 = f1[0], b1 = f1[1];
#pragma unroll
                for (int q = 0; q < 4; ++q) { Y0[2 * q] = bflo(a0[q]); Y0[2 * q + 1] = bfhi(a0[q]); Y0[8 + 2 * q] = bflo(a1[q]); Y0[8 + 2 * q + 1] = bfhi(a1[q]);
                                              Y1[2 * q] = bflo(b0[q]); Y1[2 * q + 1] = bfhi(b0[q]); Y1[8 + 2 * q] = bflo(b1[q]); Y1[8 + 2 * q + 1] = bfhi(b1[q]); }
            }
#pragma unroll
            for (int jt = 0; jt < 2; ++jt)
#pragma unroll
                for (int s2 = 0; s2 < 2; ++s2) {
                    const bf16x8_t a0 = *(const LAS bf16x8_t*)(sl + r32 * CRS + (jt * 32 + s2 * 16 + hi * 8) * 2);
                    const bf16x8_t a1 = *(const LAS bf16x8_t*)(sl + (32 + r32) * CRS + (jt * 32 + s2 * 16 + hi * 8) * 2);
                    Y0 = __builtin_amdgcn_mfma_f32_32x32x16_bf16(a0, xb[jt * 2 + s2], Y0, 0, 0, 0);
                    Y1 = __builtin_amdgcn_mfma_f32_32x32x16_bf16(a1, xb[jt * 2 + s2], Y1, 0, 0, 0);
                }
            X0 = Y0; X1 = Y1;
        } else if (lw == turn) {
            if (c + 6 < 64) CHB_LWRITE((slot == 0) ? 6 : slot - 1);
            if (c + 12 < 64) CHB_GLOAD(c + 12);
            if (c >= 1) {
                const LAS unsigned char* so = L + CHB_SOUT + ((c - 1) & 1) * CB;
                bf16_t* Sc = Sst + (size_t)(c - 1) * 4096;
#pragma unroll
                for (int q = 0; q < 8; ++q) { const int p_ = q * 64 + lane; *(u32x4_t*)((unsigned char*)Sc + p_ * 16) = *(const LAS u32x4_t*)(so + (p_ >> 3) * CRS + (p_ & 7) * 16); }
            }
        }
        turn = (turn == 5) ? 0 : turn + 1; slot = (slot == 6) ? 0 : slot + 1;
    }
    asm volatile("s_waitcnt lgkmcnt(0)" ::: "memory"); __builtin_amdgcn_s_barrier(); asm volatile("" ::: "memory");
    if (wave == 2) {
        const LAS unsigned char* so = L + CHB_SOUT + (63 & 1) * CB;
        bf16_t* Sc = Sst + (size_t)63 * 4096;
#pragma unroll
        for (int q = 0; q < 8; ++q) { const int p_ = q * 64 + lane; *(u32x4_t*)((unsigned char*)Sc + p_ * 16) = *(const LAS u32x4_t*)(so + (p_ >> 3) * CRS + (p_ & 7) * 16); }
    }
#undef CHB_GLOAD
#undef CHB_LWRITE
}
__device__ __forceinline__ void ph_chunkC(const Frame& F, const Params& P) {
    const bf16_t* Rb = (const bf16_t*)(P.ws + WS_R3 + 32 * MiB); const bf16_t* Kb = Rb + (size_t)NTOK * RW; const bf16_t* Vb = Rb + (size_t)NTOK * RW * 4;
    const bf16_t* Gb = (const bf16_t*)(P.ws + WS_G); bf16_t* XN = (bf16_t*)(P.ws + WS_XN);
    const float* ln_w = P.in[14]; const float* ln_b = P.in[15]; const float* r_k = P.in[13];
    const int gw = F.vcu * 8 + F.wave, NGW = F.G * 8, lane = F.lane, r32 = lane & 31, hi = lane >> 5;
#pragma unroll 1
    for (int job = gw; job < 4096; job += NGW) {
        const int unit = job >> 1, tt = (job & 1) * 32, bh = unit >> 6, c = unit & 63, bb = bh >> 3, hd = bh & 7;
        const unsigned char* up = P.ws + WS_BIG + (size_t)unit * CH_UNIT_BYTES;
        const bf16_t* PyT = (const bf16_t*)(up + 8192); const float* VQyT = (const float*)(up + 32768);
        const bf16_t* Sc = (const bf16_t*)(P.ws + WS_Y) + (size_t)unit * 4096;
        f32x16_t y0, y1;
#pragma unroll
        for (int r = 0; r < 16; ++r) { y0[r] = VQyT[(size_t)(tt + crow(r, hi)) * 64 + r32]; y1[r] = VQyT[(size_t)(tt + crow(r, hi)) * 64 + 32 + r32]; }
#pragma unroll
        for (int ks = 0; ks < 4; ++ks) {
            const bf16x8_t a = *(const bf16x8_t*)(PyT + (size_t)(tt + r32) * 64 + ks * 16 + hi * 8);
            const bf16x8_t b0 = *(const bf16x8_t*)(Sc + (size_t)r32 * 64 + ks * 16 + hi * 8);
            const bf16x8_t b1 = *(const bf16x8_t*)(Sc + (size_t)(32 + r32) * 64 + ks * 16 + hi * 8);
            y0 = __builtin_amdgcn_mfma_f32_32x32x16_bf16(a, b0, y0, 0, 0, 0); y1 = __builtin_amdgcn_mfma_f32_32x32x16_bf16(a, b1, y1, 0, 0, 0);
        }
        LAS float* yb = (LAS float*)(F.lds + F.wave * 8192);
#pragma unroll
        for (int r = 0; r < 16; ++r) { yb[crow(r, hi) * 64 + r32] = y0[r]; yb[crow(r, hi) * 64 + 32 + r32] = y1[r]; }
        asm volatile("s_waitcnt lgkmcnt(0)" ::: "memory");
        const int ch = hd * 64 + lane;
        const float lw = ln_w[ch], lb = ln_b[ch], rk = r_k[ch];
        const unsigned tok0 = (unsigned)(bb * SEQ + c * 64 + tt);
#pragma unroll 2
        for (int tl = 0; tl < 32; ++tl) {
            const unsigned o = (tok0 + tl) * RW + ch;
            const float yv = yb[tl * 64 + lane];
            const float rv = bf2f(Rb[o]), kv = bf2f(Kb[o]), vv = bf2f(Vb[o]), gv = bf2f(Gb[o]);
            const float mean = wsum(yv) * (1.f / 64.f), d = yv - mean;
            const float var = wsum(d * d) * (1.f / 64.f);
            const float bonus = wsum(rv * kv * rk);
            XN[(tok0 + tl) * D + ch] = (bf16_t)f2bf((d * rsqrtf(var + 64e-5f) * lw + lb + bonus * vv) * gv);
        }
        asm volatile("s_waitcnt lgkmcnt(0)" ::: "memory");
    }
}

__device__ __forceinline__ void ph_router(const Frame& F, const Params& P, int layer) {
    const float* x = P.out; const float* gnorm = P.in[2] + layer * D;
    const float* w_group = P.in[26] + (size_t)layer * D * 4; const float* b_group = P.in[27] + layer * 4;
    const float* w_expert = P.in[28] + (size_t)layer * D * 32; const float* b_expert = P.in[29] + layer * 32;
    bf16_t* XN = (bf16_t*)(P.ws + WS_XN);
    int* eid = (int*)(P.ws + WS_MISC); int* posn = eid + NASSIGN; float* wts = (float*)(posn + NASSIGN);
    unsigned* counts = (unsigned*)(P.ws + WS_CTL) + (layer ? CW_MOE1 : CW_MOE0);
    LAS float* Wl = (LAS float*)F.lds;
    for (int idx = F.tid; idx < 1024 * 36; idx += 512) { const int k = idx / 36, j = idx - k * 36; Wl[idx] = (j < 4) ? w_group[k * 4 + j] : w_expert[k * 32 + j - 4]; }
    __syncthreads();
    const int gw = F.vcu * 8 + F.wave, NGW = F.G * 8, lane = F.lane;
    for (int tok = gw; tok < NTOK; tok += NGW) {
        const float* xr = x + (size_t)tok * D + lane;
        float ss = 0.f;
#pragma unroll
        for (int m = 0; m < 16; ++m) { const float xv = xr[64 * m]; ss += xv * xv; }
        const float rs = rsqrtf(wsum(ss) * (1.f / D) + 1e-6f);
        float acc[36];
#pragma unroll
        for (int j = 0; j < 36; ++j) acc[j] = 0.f;
#pragma unroll 2
        for (int m = 0; m < 16; ++m) {
            const float hm = xr[64 * m] * rs * gnorm[lane + 64 * m];
            XN[(size_t)tok * D + lane + 64 * m] = (bf16_t)f2bf(hm);
            const LAS f32x4_t* wr = (const LAS f32x4_t*)(Wl + (lane + 64 * m) * 36);
#pragma unroll
            for (int q = 0; q < 9; ++q) { const f32x4_t w4 = wr[q]; acc[4 * q] += hm * w4.x; acc[4 * q + 1] += hm * w4.y; acc[4 * q + 2] += hm * w4.z; acc[4 * q + 3] += hm * w4.w; }
        }
        float lg[36];
#pragma unroll
        for (int j = 0; j < 36; ++j) lg[j] = wsum(acc[j]) + ((j < 4) ? b_group[j] : b_expert[j - 4]);
        int gi = 0; float gm = lg[0];
#pragma unroll
        for (int j = 1; j < 4; ++j) if (lg[j] > gm) { gm = lg[j]; gi = j; }
        float den = 0.f;
#pragma unroll
        for (int j = 0; j < 4; ++j) den += expf(lg[j] - gm);
        const float gwt = 1.f / den;
        float el[8];
#pragma unroll
        for (int j = 0; j < 8; ++j) el[j] = (gi == 0) ? lg[4 + j] : (gi == 1) ? lg[12 + j] : (gi == 2) ? lg[20 + j] : lg[28 + j];
        int i0 = 0; float v0 = el[0];
#pragma unroll
        for (int j = 1; j < 8; ++j) if (el[j] > v0) { v0 = el[j]; i0 = j; }
        int i1 = 0; float v1 = -INFINITY;
#pragma unroll
        for (int j = 0; j < 8; ++j) if (j != i0 && el[j] > v1) { v1 = el[j]; i1 = j; }
        const float e1 = expf(v1 - v0);
        const float p0 = 1.f / (1.f + e1), p1 = e1 / (1.f + e1);
        if (lane < 2) {
            const int e = gi * 8 + (lane ? i1 : i0);
            const unsigned pos = __hip_atomic_fetch_add(counts + 64 * e, 1u, __ATOMIC_RELAXED, __HIP_MEMORY_SCOPE_AGENT);
            eid[tok * 2 + lane] = e; posn[tok * 2 + lane] = (int)pos; wts[tok * 2 + lane] = (lane ? p1 : p0) * gwt;
        }
    }
    __syncthreads();
}

__device__ __forceinline__ void ph_gather(const Frame& F, const Params& P, int layer) {
    unsigned* ctl = (unsigned*)(P.ws + WS_CTL) + (layer ? CW_MOE1 : CW_MOE0);
    const bf16_t* XN = (const bf16_t*)(P.ws + WS_XN); bf16_t* Xg = (bf16_t*)(P.ws + WS_R3);
    const int* eid = (const int*)(P.ws + WS_MISC); const int* posn = eid + NASSIGN; const float* wts = (const float*)(posn + NASSIGN);
    int* tok_slot = (int*)(wts + NASSIGN); float* slot_wt = (float*)(tok_slot + NASSIGN);
    LAS int* pstart = (LAS int*)F.lds;
    if (F.tid == 0) {
        int start = 0;
        for (int e = 0; e < NEXP; ++e) {
            const int c = (int)__hip_atomic_load(ctl + 64 * e, __ATOMIC_RELAXED, __HIP_MEMORY_SCOPE_AGENT);
            const int nb = (c + MBLK - 1) / MBLK;
            pstart[e] = start;
            if (blockIdx.x == 0) for (int q = 0; q < nb; ++q) ctl[MOE_PLAN + 128 + start / MBLK + q] = (unsigned)e;
            start += nb * MBLK;
        }
        if (blockIdx.x == 0) ctl[MOE_PLAN + 96] = (unsigned)(start / MBLK);
    }
    __syncthreads();
    const int gw = F.vcu * 8 + F.wave, NGW = F.G * 8, lane = F.lane;
    for (int a = gw; a < NASSIGN; a += NGW) {
        const int slot = pstart[eid[a]] + posn[a];
        const u32x4_t* src = (const u32x4_t*)(XN + (size_t)(a >> 1) * D);
        u32x4_t* dst = (u32x4_t*)(Xg + (size_t)slot * D);
        dst[lane] = src[lane]; dst[64 + lane] = src[64 + lane];
        if (lane == 0) { tok_slot[a] = slot; slot_wt[slot] = wts[a]; }
    }
    __syncthreads();
}

template <bool FINAL> __device__ __forceinline__ void ph_combine(const Frame& F, const Params& P, const float* gnorm) {
    float* x = P.out; const bf16_t* Yb = (const bf16_t*)(P.ws + WS_BIG); bf16_t* XN = (bf16_t*)(P.ws + WS_XN);
    const int* tok_slot = (const int*)(P.ws + WS_MISC) + 3 * NASSIGN;
    const int gw = F.vcu * 8 + F.wave, NGW = F.G * 8, lane = F.lane;
    for (int tok = gw; tok < NTOK; tok += NGW) {
        const int s0 = tok_slot[tok * 2], s1 = tok_slot[tok * 2 + 1];
        f32x4_t* xr = (f32x4_t*)(x + (size_t)tok * D) + lane;
        const u32x2_t* y0 = (const u32x2_t*)(Yb + (size_t)s0 * D) + lane; const u32x2_t* y1 = (const u32x2_t*)(Yb + (size_t)s1 * D) + lane;
        f32x4_t v[4]; float ss = 0.f;
#pragma unroll
        for (int j = 0; j < 4; ++j) {
            v[j] = xr[64 * j]; const u32x2_t a = y0[64 * j], b = y1[64 * j];
            v[j].x += bflo(a.x) + bflo(b.x); v[j].y += bfhi(a.x) + bfhi(b.x); v[j].z += bflo(a.y) + bflo(b.y); v[j].w += bfhi(a.y) + bfhi(b.y);
            ss += (v[j].x * v[j].x + v[j].y * v[j].y) + (v[j].z * v[j].z + v[j].w * v[j].w);
        }
        const float rs = rsqrtf(wsum(ss) * (1.f / D) + 1e-6f);
        const f32x4_t* gr = (const f32x4_t*)gnorm + lane;
#pragma unroll
        for (int j = 0; j < 4; ++j) {
            const f32x4_t gg = gr[64 * j];
            if (FINAL) { f32x4_t o; o.x = v[j].x * rs * gg.x; o.y = v[j].y * rs * gg.y; o.z = v[j].z * rs * gg.z; o.w = v[j].w * rs * gg.w; xr[64 * j] = o; }
            else { xr[64 * j] = v[j]; u32x2_t o; o.x = pk2(v[j].x * rs * gg.x, v[j].y * rs * gg.y); o.y = pk2(v[j].z * rs * gg.z, v[j].w * rs * gg.w); ((u32x2_t*)(XN + (size_t)tok * D) + lane)[64 * j] = o; }
        }
    }
}

__device__ __forceinline__ void ph_attn_combine(const Frame& F, const Params& P) {
    const bf16_t* O = (const bf16_t*)(P.ws + WS_R3); bf16_t* XN = (bf16_t*)(P.ws + WS_XN);
    const float lambda_init = 0.35550906f;
    const int gw = F.vcu * 8 + F.wave, NGW = F.G * 8, lane = F.lane;
    const float la = wsum(P.in[20][lane] * P.in[21][lane]), lb = wsum(P.in[22][lane] * P.in[23][lane]);
    const float lam = expf(la) - expf(lb) + lambda_init;
    const float s0 = P.in[24][lane] * (1.f - lambda_init), s1 = P.in[24][64 + lane] * (1.f - lambda_init);
    for (int tok = gw; tok < NTOK; tok += NGW) {
        const bf16_t* Or = O + (size_t)tok * 2048;
#pragma unroll
        for (int h = 0; h < 8; ++h) {
            const float oa = bf2f(Or[(h * 4 + 0) * 64 + lane]) - lam * bf2f(Or[(h * 4 + 2) * 64 + lane]);
            const float ob = bf2f(Or[(h * 4 + 1) * 64 + lane]) - lam * bf2f(Or[(h * 4 + 3) * 64 + lane]);
            const float rs = rsqrtf(wsum(oa * oa + ob * ob) * (1.f / 128.f) + 1e-5f);
            XN[(size_t)tok * D + h * 128 + lane] = (bf16_t)f2bf(oa * rs * s0);
            XN[(size_t)tok * D + h * 128 + 64 + lane] = (bf16_t)f2bf(ob * rs * s1);
        }
    }
}

constexpr int N_PHASES = 20;
__device__ __forceinline__ Frame make_frame(unsigned char* lds_raw) {
    Frame F; F.lds = (LAS unsigned char*)lds_raw;
    F.tid = threadIdx.x; asm volatile("" : "+v"(F.tid));
    F.lane = F.tid & 63; F.wave = __builtin_amdgcn_readfirstlane(F.tid >> 6);
    F.G = gridDim.x; { const int bx = blockIdx.x; F.vcu = (F.G % 8 == 0) ? (bx % 8) * (F.G / 8) + bx / 8 : bx; }
    return F;
}
constexpr int PTBL_OFF = MISC_OFF + 256;
__device__ __forceinline__ Params load_params(unsigned char* lds_raw) {
    asm volatile("" ::: "memory");
    const LAS unsigned* t = (const LAS unsigned*)((LAS unsigned char*)lds_raw + PTBL_OFF);
    Params P;
#pragma unroll
    for (int i = 0; i < 33; ++i) { const unsigned lo = __builtin_amdgcn_readfirstlane(t[2 * i]), hi = __builtin_amdgcn_readfirstlane(t[2 * i + 1]); P.in[i] = (const float*)(const __attribute__((address_space(1))) float*)(((unsigned long long)hi << 32) | lo); }
    { const unsigned lo = __builtin_amdgcn_readfirstlane(t[66]), hi = __builtin_amdgcn_readfirstlane(t[67]); P.out = (float*)(__attribute__((address_space(1))) float*)(((unsigned long long)hi << 32) | lo); }
    { const unsigned lo = __builtin_amdgcn_readfirstlane(t[68]), hi = __builtin_amdgcn_readfirstlane(t[69]); P.ws = (unsigned char*)(__attribute__((address_space(1))) unsigned char*)(((unsigned long long)hi << 32) | lo); }
    P.ph_lo = (int)__builtin_amdgcn_readfirstlane(t[70]); P.ph_hi = (int)__builtin_amdgcn_readfirstlane(t[71]);
    return P;
}
__global__ void __launch_bounds__(512, 2) mega(Params Parg) {
    extern __shared__ __attribute__((aligned(16))) unsigned char lds_raw[];
    {
        volatile LAS unsigned* MISC = (volatile LAS unsigned*)((LAS unsigned char*)lds_raw + MISC_OFF);
        if (threadIdx.x < 32) MISC[threadIdx.x] = 0u;
        const unsigned* ka = (const unsigned*)__builtin_amdgcn_kernarg_segment_ptr();
        if (threadIdx.x < 72) ((LAS unsigned*)((LAS unsigned char*)lds_raw + PTBL_OFF))[threadIdx.x] = ka[threadIdx.x];
        __syncthreads();
    }
    const int ph_lo = load_params(lds_raw).ph_lo, ph_hi = load_params(lds_raw).ph_hi;
    if (ph_hi - ph_lo > 1) { (void)xcd_barrier_post((unsigned*)(load_params(lds_raw).ws + WS_CTL) + CW_BAR, (volatile LAS unsigned*)((LAS unsigned char*)lds_raw + MISC_OFF) + 8); }
#define IN(k) (ph_lo <= (k) && (k) < ph_hi)
#define SEAM(k) do { if (IN(k) && IN((k) + 1)) { XcdBarrier bar_; bar_.bar = (unsigned*)(load_params(lds_raw).ws + WS_CTL) + CW_BAR; bar_.x = xb_xcc_id(); \
        bar_.st = (volatile LAS unsigned*)((LAS unsigned char*)lds_raw + MISC_OFF) + 8; xcd_barrier(bar_); } } while (0)
#ifndef PROBE_MASK
#define PROBE_MASK 0
#endif
#define REP(k) ((PROBE_MASK >> (k)) & 1)
#define FORCE_BAR do { XcdBarrier bar_; bar_.bar = (unsigned*)(load_params(lds_raw).ws + WS_CTL) + CW_BAR; bar_.x = xb_xcc_id(); \
        bar_.st = (volatile LAS unsigned*)((LAS unsigned char*)lds_raw + MISC_OFF) + 8; xcd_barrier(bar_); } while (0)
#define WSB(off) ((bf16_t*)(P.ws + (off)))
    if (IN(0)) for (int rep_ = 0; rep_ <= REP(0); ++rep_) { if (rep_) FORCE_BAR; const Params P = load_params(lds_raw); const Frame F = make_frame(lds_raw); ph_prologue(F, P); }
    SEAM(0);
    if (IN(1)) for (int rep_ = 0; rep_ <= REP(1); ++rep_) { if (rep_) FORCE_BAR; const Params P = load_params(lds_raw); pg8::Gemm g{WSB(WS_XN), WSB(WS_WIN), NTOK, INW, D, 0}; pg8::EpiBf16Plain E{WSB(WS_BIG), INW, 0}; pg8::PlainOrder S{}; S.init(NTOK, INW, (int)gridDim.x, (int)blockIdx.x);
        pg8::gemm_phase<pg8::EpiBf16Plain, pg8::PlainOrder, true, true>((LAS unsigned char*)lds_raw, g, S, E); }
    SEAM(1);
    if (IN(2)) for (int rep_ = 0; rep_ <= REP(2); ++rep_) { if (rep_) FORCE_BAR; const Params P = load_params(lds_raw); const Frame F = make_frame(lds_raw); ph_prep(F, P); }
    SEAM(2);
    if (IN(3)) for (int rep_ = 0; rep_ <= REP(3); ++rep_) { if (rep_) FORCE_BAR; const Params P = load_params(lds_raw); const Frame F = make_frame(lds_raw); ph_chunkA(F, P); }
    SEAM(3);
    if (IN(4)) for (int rep_ = 0; rep_ <= REP(4); ++rep_) { if (rep_) FORCE_BAR; const Params P = load_params(lds_raw); const Frame F = make_frame(lds_raw); ph_chunkB(F, P); FORCE_BAR; asm volatile("" ::: "memory"); { const Params P2 = load_params(lds_raw); const Frame F2 = make_frame(lds_raw); ph_chunkC(F2, P2); } }
    SEAM(4);
    if (IN(5)) for (int rep_ = 0; rep_ <= REP(5); ++rep_) { if (rep_) FORCE_BAR; const Params P = load_params(lds_raw); pg8::Gemm g{WSB(WS_XN), WSB(WS_WOUT), NTOK, D, D, 0}; pg8::EpiResF32 E{P.in[0], P.out, D, 0}; pg8::PlainOrder S{}; S.init(NTOK, D, (int)gridDim.x, (int)blockIdx.x);
        pg8::gemm_phase<pg8::EpiResF32, pg8::PlainOrder, true, true>((LAS unsigned char*)lds_raw, g, S, E); }
    SEAM(5);
#define MOE_PHASES(layer, pb) \
    if (IN(pb)) for (int rep_ = 0; rep_ <= REP(pb); ++rep_) { if (rep_) FORCE_BAR; const Params P = load_params(lds_raw); const Frame F = make_frame(lds_raw); ph_router(F, P, layer); } \
    SEAM(pb); \
    if (IN((pb) + 1)) for (int rep_ = 0; rep_ <= REP((pb) + 1); ++rep_) { if (rep_) FORCE_BAR; const Params P = load_params(lds_raw); const Frame F = make_frame(lds_raw); ph_gather(F, P, layer); } \
    SEAM((pb) + 1); \
    if (IN((pb) + 2)) for (int rep_ = 0; rep_ <= REP((pb) + 2); ++rep_) { if (rep_) FORCE_BAR; const Params P = load_params(lds_raw); const int* lctl = (const int*)(P.ws + WS_CTL) + ((layer) ? CW_MOE1 : CW_MOE0) + MOE_PLAN; \
        pg8::Gemm g{WSB(WS_R3), WSB(WS_W1T) + (size_t)(layer) * NEXP * 1024 * D, PMAX, 1024, D, 0}; pg8::EpiSwiglu E{WSB(WS_R3) + (size_t)40 * MiB}; \
        pg8::GroupedOrder S{lctl, (size_t)1024 * D * 2, 4, 0, 0, 0}; S.bind((int)gridDim.x, (int)blockIdx.x); \
        pg8::gemm_phase<pg8::EpiSwiglu, pg8::GroupedOrder, true, true>((LAS unsigned char*)lds_raw, g, S, E); } \
    SEAM((pb) + 2); \
    if (IN((pb) + 3)) for (int rep_ = 0; rep_ <= REP((pb) + 3); ++rep_) { if (rep_) FORCE_BAR; const Params P = load_params(lds_raw); const int* lctl = (const int*)(P.ws + WS_CTL) + ((layer) ? CW_MOE1 : CW_MOE0) + MOE_PLAN; \
        pg8::Gemm g{WSB(WS_R3) + (size_t)40 * MiB, WSB(WS_W2T) + (size_t)(layer) * NEXP * D * MH, PMAX, D, MH, 0}; \
        pg8::EpiScaleBf16 E{WSB(WS_BIG), (const float*)(P.ws + WS_MISC) + 4 * NASSIGN, D, 0}; \
        pg8::GroupedOrder S{lctl, (size_t)D * MH * 2, 4, 0, 0, 0}; S.bind((int)gridDim.x, (int)blockIdx.x); \
        pg8::gemm_phase<pg8::EpiScaleBf16, pg8::GroupedOrder, true, true>((LAS unsigned char*)lds_raw, g, S, E); } \
    SEAM((pb) + 3);

    MOE_PHASES(0, 6)
    if (IN(10)) for (int rep_ = 0; rep_ <= REP(10); ++rep_) { if (rep_) FORCE_BAR; const Params P = load_params(lds_raw); const Frame F = make_frame(lds_raw); ph_combine<false>(F, P, P.in[1] + D); }
    SEAM(10);
    if (IN(11)) for (int rep_ = 0; rep_ <= REP(11); ++rep_) { if (rep_) FORCE_BAR; const Params P = load_params(lds_raw); pg8::Gemm g{WSB(WS_XN), WSB(WS_WQKV), NTOK, QKVW, D, 0}; pg8::EpiQKV E{WSB(WS_BIG), (const float*)(P.ws + WS_SMALLW + 393216), attn_body::C2, 0};
        pg8::PlainOrder S{}; S.init(NTOK, QKVW, (int)gridDim.x, (int)blockIdx.x);
        pg8::gemm_phase<pg8::EpiQKV, pg8::PlainOrder, true, true>((LAS unsigned char*)lds_raw, g, S, E); }
    SEAM(11);
    if (IN(12)) for (int rep_ = 0; rep_ <= REP(12); ++rep_) { if (rep_) FORCE_BAR; const Params P = load_params(lds_raw); const attn_body::AttnTensors AT{(const attn_body::bf16*)WSB(WS_BIG), (const attn_body::bf16*)(WSB(WS_BIG) + 1024), (const attn_body::bf16*)(WSB(WS_BIG) + 2048), (attn_body::bf16*)WSB(WS_R3)};
        const attn_body::StaticOrder S((int)gridDim.x, (int)blockIdx.x);
        attn_body::attn_phase<attn_body::StaticOrder>((char*)lds_raw, AT, S); }
    SEAM(12);
    if (IN(13)) for (int rep_ = 0; rep_ <= REP(13); ++rep_) { if (rep_) FORCE_BAR; const Params P = load_params(lds_raw); const Frame F = make_frame(lds_raw); ph_attn_combine(F, P); }
    SEAM(13);
    if (IN(14)) for (int rep_ = 0; rep_ <= REP(14); ++rep_) { if (rep_) FORCE_BAR; const Params P = load_params(lds_raw); pg8::Gemm g{WSB(WS_XN), WSB(WS_CWOUT), NTOK, D, D, 0}; pg8::EpiResF32 E{P.out, P.out, D, 0}; pg8::PlainOrder S{}; S.init(NTOK, D, (int)gridDim.x, (int)blockIdx.x);
        pg8::gemm_phase<pg8::EpiResF32, pg8::PlainOrder, true, true>((LAS unsigned char*)lds_raw, g, S, E); }
    SEAM(14);
    MOE_PHASES(1, 15)
    if (IN(19)) for (int rep_ = 0; rep_ <= REP(19); ++rep_) { if (rep_) FORCE_BAR; const Params P = load_params(lds_raw); const Frame F = make_frame(lds_raw); ph_combine<true>(F, P, P.in[3]); }
#undef MOE_PHASES
#undef IN
#undef SEAM
#undef WSB
}

#ifdef DBG_STAGES
__global__ void __launch_bounds__(512, 2) dbgA(Params P) { extern __shared__ __attribute__((aligned(16))) unsigned char l[]; const Frame F = make_frame(l); ph_chunkA(F, P); }
__global__ void __launch_bounds__(512, 2) dbgB(Params P) { extern __shared__ __attribute__((aligned(16))) unsigned char l[]; const Frame F = make_frame(l); ph_chunkB(F, P); }
__global__ void __launch_bounds__(512, 2) dbgC(Params P) { extern __shared__ __attribute__((aligned(16))) unsigned char l[]; const Frame F = make_frame(l); ph_chunkC(F, P); }
__global__ void __launch_bounds__(512, 2) dbgPrep(Params P) { extern __shared__ __attribute__((aligned(16))) unsigned char l[]; const Frame F = make_frame(l); ph_prep(F, P); }
__global__ void __launch_bounds__(512, 2) dbgRouter(Params P) { extern __shared__ __attribute__((aligned(16))) unsigned char l[]; const Frame F = make_frame(l); ph_router(F, P, 1); }
#endif
}

extern "C" void kernel_launch(void* const* d_in, const int* in_sizes, int n_in, void* d_out, int out_size, void* d_ws, size_t ws_size,
                              hipStream_t stream) {
    static int grid = 0;
    if (grid == 0) {
        (void)hipFuncSetAttribute((const void*)mega, hipFuncAttributeMaxDynamicSharedMemorySize, LDS_BYTES);
        int dev = 0, cus = 0, per_cu = 0;
        (void)hipGetDevice(&dev); (void)hipDeviceGetAttribute(&cus, hipDeviceAttributeMultiprocessorCount, dev);
        (void)hipOccupancyMaxActiveBlocksPerMultiprocessor(&per_cu, (const void*)mega, 512, LDS_BYTES);
        (void)hipGetLastError();
        grid = (per_cu >= 1 && cus > 0) ? cus : 256;
    }
    (void)hipMemsetAsync((char*)d_ws + WS_CTL, 0, CTL_ZERO_BYTES, stream);
    Params P{};
    for (int i = 0; i < 33; ++i) P.in[i] = (const float*)d_in[i];
    P.out = (float*)d_out; P.ws = (unsigned char*)d_ws;
#if MK_PER_PHASE
    for (int ph = 0; ph < N_PHASES; ++ph) { P.ph_lo = ph; P.ph_hi = ph + 1; hipLaunchKernelGGL(mega, dim3(grid), dim3(512), LDS_BYTES, stream, P); }
#else
    P.ph_lo = 0; P.ph_hi = N_PHASES;
    hipLaunchKernelGGL(mega, dim3(grid), dim3(512), LDS_BYTES, stream, P);
#endif
}
```

```cpp
#define MK_PER_PHASE 0
#include <hip/hip_runtime.h>
#include <stdint.h>
#include <math.h>

#define LAS __attribute__((address_space(3)))
typedef unsigned short bf16_t;
typedef unsigned u32x4_t __attribute__((ext_vector_type(4)));
typedef unsigned u32x2_t __attribute__((ext_vector_type(2)));

namespace {
constexpr int D = 1024, SEQ = 4096, NTOK = 16384;
constexpr int RW = 512;
constexpr int SHIFTW = 1792, INW = 2304, QKVW = 3072;
constexpr int NEXP = 32, MH = 512, MBLK = 256;
constexpr int NASSIGN = NTOK * 2;
constexpr int NBLK_MAX = 159;
constexpr int PMAX = NBLK_MAX * MBLK;

__device__ __forceinline__ unsigned f2bf(float f) { unsigned u = __builtin_bit_cast(unsigned, f); return (u + 0x7fffu + ((u >> 16) & 1u)) >> 16; }
__device__ __forceinline__ unsigned pk2(float lo, float hi) { return f2bf(lo) | (f2bf(hi) << 16); }
__device__ __forceinline__ float bf2f(bf16_t b) { return __builtin_bit_cast(float, (unsigned)b << 16); }
__device__ __forceinline__ float bflo(unsigned w) { return __builtin_bit_cast(float, w << 16); }
__device__ __forceinline__ float bfhi(unsigned w) { return __builtin_bit_cast(float, w & 0xffff0000u); }

__device__ __forceinline__ float wave_sum(float v) {
#pragma unroll
    for (int o = 32; o > 0; o >>= 1) v += __shfl_xor(v, o);
    return v;
}
__device__ __forceinline__ float wave_max(float v) {
#pragma unroll
    for (int o = 32; o > 0; o >>= 1) v = fmaxf(v, __shfl_xor(v, o));
    return v;
}
__device__ __forceinline__ float block_sum(float v, float* red) {
    v = wave_sum(v);
    const int w = threadIdx.x >> 6, nw = blockDim.x >> 6;
    __syncthreads();
    if ((threadIdx.x & 63) == 0) red[w] = v;
    __syncthreads();
    float s = 0.f;
    for (int i = 0; i < nw; ++i) s += red[i];
    return s;
}
__device__ __forceinline__ float block_max(float v, float* red) {
    v = wave_max(v);
    const int w = threadIdx.x >> 6, nw = blockDim.x >> 6;
    __syncthreads();
    if ((threadIdx.x & 63) == 0) red[w] = v;
    __syncthreads();
    float s = -INFINITY;
    for (int i = 0; i < nw; ++i) s = fmaxf(s, red[i]);
    return s;
}
__device__ __forceinline__ float sigmoidf_(float x) { return 1.f / (1.f + expf(-x)); }
}
namespace pg8 {
#define PG8_LAS __attribute__((address_space(3)))
typedef unsigned short bf16_t;
typedef short bf16x8 __attribute__((ext_vector_type(8)));
typedef float f32x4 __attribute__((ext_vector_type(4)));
typedef unsigned u32x4 __attribute__((ext_vector_type(4)));
constexpr int BM = 256, BK = 64, HALF = 128, HTB = HALF * BK * 2  , STAGE_BYTES = 8 * HTB, NXCD = 8, WGM = 8;

__host__ __device__ __forceinline__ int lds_byte(int r, int c) { const int st = (r >> 4) * 2 + (c >> 5), rr = r & 15, cc = c & 31, ob = rr * 64 + cc * 2; return st * 1024 + (ob ^ (((ob >> 9) & 1) << 5)); }
__host__ __device__ __forceinline__ void stage_rc(int b, int& R, int& C) { const int st = b / 1024, sb = b % 1024, swz = sb ^ (((sb >> 9) & 1) << 5); R = (st >> 1) * 16 + swz / 64; C = (st & 1) * 32 + (swz % 64) / 2; }
__host__ __device__ __forceinline__ int perm32(int rho) { const int n = rho >> 4, i = rho & 15; return 8 * (i >> 2) + 4 * n + (i & 3); }

struct Unit { int pm, pn; size_t boff; int aux0, aux1; };
struct Gemm { const bf16_t* A; const bf16_t* Bt; int M, N, K, pad; };

struct StaticOrder {
    static constexpr bool GATHER = false;
    __device__ __forceinline__ int row_of(const Unit&, int) const { return 0; }
    int nM, nN, nwg, G, c, pad;
    __host__ __device__ void init(int M, int N, int G_, int c_) { nM = M / BM; nN = N / BM; nwg = nM * nN; G = G_; c = c_; }
    __host__ __device__ bool next(int i, Unit& u) const {
        const long L = (long)i * G + c; if (L >= nwg) return false;
        int wgid = (int)L; { const int q = nwg / NXCD, r = nwg % NXCD, xcd = wgid % NXCD, off = wgid / NXCD; wgid = (xcd < r ? xcd * (q + 1) : r * (q + 1) + (xcd - r) * q) + off; }
        const int nig = WGM * nN, gid = wgid / nig, fm = gid * WGM, gsz = (nM - fm) < WGM ? (nM - fm) : WGM;
        u.pm = fm + ((wgid % nig) % gsz); u.pn = (wgid % nig) / gsz; u.boff = 0; u.aux0 = 0; u.aux1 = 0; return true;
    }
    __device__ __forceinline__ void a_ready(const Unit&) const {}
    __device__ __forceinline__ void done(const Unit&) const {}
};
__device__ __forceinline__ unsigned cvt_pk_bf16(float lo, float hi) { unsigned r; asm volatile("v_cvt_pk_bf16_f32 %0, %1, %2" : "=v"(r) : "v"(lo), "v"(hi)); return r; }

struct EpiBf16Plain {
    static constexpr bool PERM = true, AFTER_DRAIN = false;
    bf16_t* O; int ldc, pad;
    __device__ __forceinline__ void operator()(const f32x4 (&acc)[2][2][4][2], const Unit& u, int wr, int wc, int fr, int fq) const {
        const int row0 = u.pm * BM + wr * 64 + fr, col0 = u.pn * BM + wc * 32 + 8 * fq;
#pragma unroll
        for (int ai = 0; ai < 2; ++ai)
#pragma unroll
            for (int m = 0; m < 4; ++m) { bf16_t* rowp = O + (size_t)(row0 + ai * HALF + m * 16) * ldc + col0;
#pragma unroll
                for (int bj = 0; bj < 2; ++bj) { const f32x4 v0 = acc[ai][bj][m][0], v1 = acc[ai][bj][m][1];
                    u32x4 w; w.x = cvt_pk_bf16(v0[0], v0[1]); w.y = cvt_pk_bf16(v0[2], v0[3]); w.z = cvt_pk_bf16(v1[0], v1[1]); w.w = cvt_pk_bf16(v1[2], v1[3]);
                    *(u32x4*)(rowp + bj * HALF) = w; } }
    }
};
struct EpiResF32 {
    static constexpr bool PERM = false, AFTER_DRAIN = false;
    const float* base; float* out; int ldc, pad;
    __device__ __forceinline__ void operator()(const f32x4 (&acc)[2][2][4][2], const Unit& u, int wr, int wc, int fr, int fq) const {
        const int row0 = u.pm * BM + wr * 64 + fr, col0 = u.pn * BM + wc * 32 + 4 * fq;
#pragma unroll
        for (int ai = 0; ai < 2; ++ai)
#pragma unroll
            for (int m = 0; m < 4; ++m) { const size_t off = (size_t)(row0 + ai * HALF + m * 16) * ldc + col0;
#pragma unroll
                for (int bj = 0; bj < 2; ++bj)
#pragma unroll
                    for (int n = 0; n < 2; ++n) { const size_t o = off + bj * HALF + n * 16; *(f32x4*)(out + o) = *(const f32x4*)(base + o) + acc[ai][bj][m][n]; } }
    }
};
__device__ __forceinline__ float silu_mul(float g, float uu) { return g * __builtin_amdgcn_rcpf(1.f + __builtin_amdgcn_exp2f(-1.4426950408889634f * g)) * uu; }
struct EpiSwiglu {
    static constexpr bool PERM = true, AFTER_DRAIN = false;
    bf16_t* H;
    __device__ __forceinline__ void operator()(const f32x4 (&acc)[2][2][4][2], const Unit& u, int wr, int wc, int fr, int fq) const {
        const int row0 = u.pm * BM + wr * 64 + fr, col0 = u.pn * 128 + wc * 32 + 8 * fq;
#pragma unroll
        for (int ai = 0; ai < 2; ++ai)
#pragma unroll
            for (int m = 0; m < 4; ++m) { bf16_t* rowp = H + (size_t)(row0 + ai * HALF + m * 16) * 512 + col0;
                const f32x4 g0 = acc[ai][0][m][0], g1 = acc[ai][0][m][1], u0 = acc[ai][1][m][0], u1 = acc[ai][1][m][1];
                u32x4 w; w.x = cvt_pk_bf16(silu_mul(g0[0], u0[0]), silu_mul(g0[1], u0[1])); w.y = cvt_pk_bf16(silu_mul(g0[2], u0[2]), silu_mul(g0[3], u0[3]));
                w.z = cvt_pk_bf16(silu_mul(g1[0], u1[0]), silu_mul(g1[1], u1[1])); w.w = cvt_pk_bf16(silu_mul(g1[2], u1[2]), silu_mul(g1[3], u1[3]));
                *(u32x4*)rowp = w; }
    }
};

struct EpiQKV {
    static constexpr bool PERM = true, AFTER_DRAIN = false;
    bf16_t* O; const float* cs; float qscale; int pad;
    __device__ __forceinline__ void operator()(const f32x4 (&acc)[2][2][4][2], const Unit& u, int wr, int wc, int fr, int fq) const {
        const int row0 = u.pm * BM + wr * 64 + fr, col0 = u.pn * BM + wc * 32 + 8 * fq;
        const bool rope = (u.pn < 8) && ((wc & 1) == 0);
        const float sc = (u.pn < 4) ? qscale : 1.f;
        const float sgn = (fq == 0) ? -1.f : 1.f; const bool act = fq < 2;
#pragma unroll
        for (int ai = 0; ai < 2; ++ai)
#pragma unroll
            for (int m = 0; m < 4; ++m) { const int row = row0 + ai * HALF + m * 16; bf16_t* rowp = O + (size_t)row * 3072 + col0;
                f32x4 cs0 = {1.f, 0.f, 1.f, 0.f}, cs1 = cs0, cs2 = cs0, cs3 = cs0;
                if (rope) { const f32x4* cp = (const f32x4*)(cs + (size_t)(row & 4095) * 16); cs0 = cp[0]; cs1 = cp[1]; cs2 = cp[2]; cs3 = cp[3]; }
#pragma unroll
                for (int bj = 0; bj < 2; ++bj) { f32x4 v0 = acc[ai][bj][m][0], v1 = acc[ai][bj][m][1];
                    if (rope) {
                        f32x4 p0, p1;
#pragma unroll
                        for (int j = 0; j < 4; ++j) { p0[j] = __shfl_xor(v0[j], 16); p1[j] = __shfl_xor(v1[j], 16); }
                        if (act) {
                            v0[0] = v0[0] * cs0[0] + sgn * p0[0] * cs0[1]; v0[1] = v0[1] * cs0[2] + sgn * p0[1] * cs0[3];
                            v0[2] = v0[2] * cs1[0] + sgn * p0[2] * cs1[1]; v0[3] = v0[3] * cs1[2] + sgn * p0[3] * cs1[3];
                            v1[0] = v1[0] * cs2[0] + sgn * p1[0] * cs2[1]; v1[1] = v1[1] * cs2[2] + sgn * p1[1] * cs2[3];
                            v1[2] = v1[2] * cs3[0] + sgn * p1[2] * cs3[1]; v1[3] = v1[3] * cs3[2] + sgn * p1[3] * cs3[3];
                        }
                    }
                    v0 = v0 * sc; v1 = v1 * sc;
                    u32x4 w; w.x = cvt_pk_bf16(v0[0], v0[1]); w.y = cvt_pk_bf16(v0[2], v0[3]); w.z = cvt_pk_bf16(v1[0], v1[1]); w.w = cvt_pk_bf16(v1[2], v1[3]);
                    *(u32x4*)(rowp + bj * HALF) = w; }
                asm volatile("" ::: "memory"); }
    }
};
struct EpiScaleBf16 {
    static constexpr bool PERM = true, AFTER_DRAIN = false;
    bf16_t* O; const float* rs; int ldc, pad;
    __device__ __forceinline__ void operator()(const f32x4 (&acc)[2][2][4][2], const Unit& u, int wr, int wc, int fr, int fq) const {
        const int row0 = u.pm * BM + wr * 64 + fr, col0 = u.pn * BM + wc * 32 + 8 * fq;
        const float* rsl = rs + (size_t)u.aux0 * 16384 + u.aux1 * 256 - u.pm * BM;
#pragma unroll
        for (int ai = 0; ai < 2; ++ai)
#pragma unroll
            for (int m = 0; m < 4; ++m) { const int row = row0 + ai * HALF + m * 16; const float s = rsl[row]; bf16_t* rowp = O + (size_t)row * ldc + col0;
#pragma unroll
                for (int bj = 0; bj < 2; ++bj) { const f32x4 v0 = acc[ai][bj][m][0] * s, v1 = acc[ai][bj][m][1] * s;
                    u32x4 w; w.x = cvt_pk_bf16(v0[0], v0[1]); w.y = cvt_pk_bf16(v0[2], v0[3]); w.z = cvt_pk_bf16(v1[0], v1[1]); w.w = cvt_pk_bf16(v1[2], v1[3]);
                    *(u32x4*)(rowp + bj * HALF) = w; } }
    }
};
template <bool GATHER_> struct GroupedOrderT {
    static constexpr bool GATHER = GATHER_;
    const PG8_LAS int* plan; const int* list; size_t estride; int nN, G, v, pad;
    __device__ __forceinline__ void bind(int G_, int c) { G = G_; v = (G_ % 8 == 0) ? (c % 8) * (G_ / 8) + c / 8 : c; }
    __device__ __forceinline__ bool next(int i, Unit& u) const {
        const int nblk = __builtin_amdgcn_readfirstlane(plan[64]);
        const long L = (long)i * G + v; if (L >= (long)nblk * nN) return false;
        u.pm = (int)(L / nN); u.pn = (int)(L % nN);
        const int e = __builtin_amdgcn_readfirstlane(plan[65 + u.pm]);
        u.aux0 = e; u.aux1 = u.pm - __builtin_amdgcn_readfirstlane(plan[32 + e]); u.boff = (size_t)e * estride; return true; }
    __device__ __forceinline__ int row_of(const Unit& u, int r) const { const int pos = u.aux1 * 256 + r; return pos < plan[u.aux0] ? list[u.aux0 * 16384 + pos] : 0; }
    __device__ __forceinline__ void a_ready(const Unit&) const {}
    __device__ __forceinline__ void done(const Unit&) const {}
};
struct PlainOrder : StaticOrder {
    __device__ __forceinline__ void bind(int G_, int c_) { G = G_; c = c_; }
};
template <class Epi, class Sched, bool ALIGN_EPI = false, bool SP2 = false>
__device__ __forceinline__ void gemm_phase(PG8_LAS unsigned char* lds, const Gemm g, const Sched& S, const Epi& E) {
    const int tid = threadIdx.x, wid = __builtin_amdgcn_readfirstlane(tid >> 6), lane = tid & 63, wr = wid >> 2, wc = wid & 3, fr = lane & 15, fq = lane >> 4;
    const int K = g.K, nt = K / BK;
    unsigned voffA[2], voffB[2];
#pragma unroll
    for (int i = 0; i < 2; ++i) { int R, C; stage_rc(tid * 16 + i * 8192, R, C); const int Rb = Epi::PERM ? ((R & ~31) + perm32(R & 31)) : R;
        voffA[i] = (unsigned)(R * K + C) * 2u; voffB[i] = (unsigned)(Rb * K + C) * 2u; }
    const size_t kstep = (size_t)(BK * 2);
    const size_t hstep = (size_t)HALF * K * 2;
    const size_t tstep = 2 * hstep;
    const unsigned ldsw = (unsigned)wid * 1024u;
    const int aoff = lds_byte(wr * 64 + fr, fq * 8), boff = lds_byte(wc * 32 + fr, fq * 8);
#define PG8_SA(b, h) (((b) * 2 + (h)) * HTB)
#define PG8_SB(b, h) ((4 + (b) * 2 + (h)) * HTB)
#define PG8_STAGE(bufoff, gbase, voff) do { _Pragma("unroll") for (int _i = 0; _i < 2; ++_i) \
        __builtin_amdgcn_global_load_lds((const unsigned*)((const char*)(gbase) + (voff)[_i]), (PG8_LAS unsigned*)(lds + (bufoff) + ldsw + _i * 8192), 16, 0, 0); } while (0)
#define PG8_STAGE_A(bufoff, base, h, seln) do { if constexpr (Sched::GATHER) { unsigned vv_[2]; vv_[0] = (seln) ? gn[h][0] : gv[h][0]; vv_[1] = (seln) ? gn[h][1] : gv[h][1]; PG8_STAGE(bufoff, base, vv_); } \
        else { PG8_STAGE(bufoff, (base) + (h) * hstep, voffA); } } while (0)
#define PG8_ROWS(u_, dst) do { _Pragma("unroll") for (int h_ = 0; h_ < 2; ++h_) _Pragma("unroll") for (int i_ = 0; i_ < 2; ++i_) { int R_, C_; stage_rc(tid * 16 + i_ * 8192, R_, C_); \
        dst[h_][i_] = (unsigned)(S.row_of(u_, h_ * HALF + R_) * K + C_) * 2u; } } while (0)
#define PG8_LDA(dst, b, h) do { _Pragma("unroll") for (int m = 0; m < 4; ++m) _Pragma("unroll") for (int k = 0; k < 2; ++k) dst[m][k] = *(const PG8_LAS bf16x8*)(lds + PG8_SA(b, h) + aoff + m * 2048 + k * 1024); } while (0)
#define PG8_LDB(dst, b, h) do { _Pragma("unroll") for (int n = 0; n < 2; ++n) _Pragma("unroll") for (int k = 0; k < 2; ++k) dst[n][k] = *(const PG8_LAS bf16x8*)(lds + PG8_SB(b, h) + boff + n * 2048 + k * 1024); } while (0)
#define PG8_MMA(ai, bj, At, Bt) do { __builtin_amdgcn_s_setprio(1); _Pragma("unroll") for (int m = 0; m < 4; ++m) _Pragma("unroll") for (int n = 0; n < 2; ++n) _Pragma("unroll") for (int k = 0; k < 2; ++k) \
        acc[ai][bj][m][n] = __builtin_amdgcn_mfma_f32_16x16x32_bf16(Bt[n][k], At[m][k], acc[ai][bj][m][n], 0, 0, 0); __builtin_amdgcn_s_setprio(0); } while (0)
#define PG8_WAIT_V(n) asm volatile("s_waitcnt vmcnt(" #n ")" ::: "memory")
#define PG8_WAIT_L(n) asm volatile("s_waitcnt lgkmcnt(" #n ")" ::: "memory")
#define PG8_BAR __builtin_amdgcn_s_barrier()
#define PG8_SCHED __builtin_amdgcn_sched_barrier(0)
    Unit cur, nxt; int ui = 0;
    if (!S.next(0, cur)) return;
    f32x4 acc[2][2][4][2];
#pragma unroll
    for (int a = 0; a < 2; ++a)
#pragma unroll
        for (int b = 0; b < 2; ++b)
#pragma unroll
            for (int m = 0; m < 4; ++m)
#pragma unroll
                for (int n = 0; n < 2; ++n) acc[a][b][m][n] = (f32x4){0.f, 0.f, 0.f, 0.f};
    bf16x8 At[4][2], B0[2][2], B1[2][2];
    unsigned gv[2][2] = {{0u, 0u}, {0u, 0u}}, gn[2][2] = {{0u, 0u}, {0u, 0u}};
    if constexpr (Sched::GATHER) PG8_ROWS(cur, gv);
    const char* cA = (const char*)g.A + (Sched::GATHER ? (size_t)0 : (size_t)cur.pm * tstep); const char* cB = (const char*)g.Bt + cur.boff + (size_t)cur.pn * tstep;
    S.a_ready(cur);
    if constexpr (SP2) {
        PG8_STAGE(PG8_SB(0, 0), cB, voffB); PG8_STAGE(PG8_SB(0, 1), cB + hstep, voffB); PG8_STAGE_A(PG8_SA(0, 0), cA, 0, false); PG8_STAGE_A(PG8_SA(0, 1), cA, 1, false);
        if (wr == 1) PG8_BAR;
        PG8_WAIT_V(2); PG8_BAR;
        PG8_STAGE(PG8_SB(1, 0), cB + kstep, voffB); PG8_STAGE_A(PG8_SA(1, 0), cA + kstep, 0, false); PG8_STAGE(PG8_SB(1, 1), cB + hstep + kstep, voffB);
        PG8_WAIT_V(6); PG8_BAR;
    } else {
        PG8_STAGE(PG8_SB(0, 0), cB, voffB); PG8_STAGE(PG8_SA(0, 0), cA, voffA); PG8_STAGE(PG8_SB(0, 1), cB + hstep, voffB); PG8_STAGE(PG8_SA(0, 1), cA + hstep, voffA);
        if (wr == 1) PG8_BAR;
        PG8_WAIT_V(4); PG8_BAR;
        PG8_STAGE(PG8_SB(1, 0), cB + kstep, voffB); PG8_STAGE(PG8_SA(1, 0), cA + kstep, voffA); PG8_STAGE(PG8_SB(1, 1), cB + hstep + kstep, voffB);
        PG8_WAIT_V(6); PG8_BAR;
    }
    for (;;) {
        const bool has_next = S.next(ui + 1, nxt);
        if constexpr (Sched::GATHER) { if (has_next) PG8_ROWS(nxt, gn); }
        const char* nA = has_next ? (const char*)g.A + (Sched::GATHER ? (size_t)0 : (size_t)nxt.pm * tstep) : cA; const char* nB = has_next ? (const char*)g.Bt + nxt.boff + (size_t)nxt.pn * tstep : cB;
        for (int t = 0; t < nt; t += 2) {
            const bool last = (t == nt - 2); const bool seln = last && has_next;
            const char* a1 = cA + (size_t)(t + 1) * kstep;
            const char* a2 = last ? nA : cA + (size_t)(t + 2) * kstep; const char* b2 = last ? nB : cB + (size_t)(t + 2) * kstep;
            const char* a3 = a2 + kstep; const char* b3 = b2 + kstep;
            if (last && has_next) S.a_ready(nxt);
            if constexpr (SP2) {
            PG8_LDB(B0, 0, 0); PG8_LDB(B1, 0, 1); PG8_SCHED; PG8_LDA(At, 0, 0); PG8_STAGE_A(PG8_SA(1, 1), a1, 1, false);
            PG8_WAIT_V(8); PG8_WAIT_L(0); PG8_BAR; PG8_MMA(0, 0, At, B0); PG8_MMA(0, 1, At, B1); PG8_BAR; PG8_SCHED;
            PG8_LDA(At, 0, 1); PG8_STAGE(PG8_SB(0, 0), b2, voffB); PG8_STAGE(PG8_SB(0, 1), b2 + hstep, voffB); PG8_STAGE_A(PG8_SA(0, 0), a2, 0, seln);
            PG8_WAIT_V(8); PG8_WAIT_L(0); PG8_BAR; PG8_MMA(1, 0, At, B0); PG8_MMA(1, 1, At, B1); PG8_BAR; PG8_SCHED;
            PG8_LDB(B0, 1, 0); PG8_LDB(B1, 1, 1); PG8_SCHED; PG8_LDA(At, 1, 0); PG8_STAGE_A(PG8_SA(0, 1), a2, 1, seln);
            PG8_WAIT_V(8); PG8_WAIT_L(0); PG8_BAR; PG8_MMA(0, 0, At, B0); PG8_MMA(0, 1, At, B1); PG8_BAR; PG8_SCHED;
            PG8_LDA(At, 1, 1); PG8_STAGE(PG8_SB(1, 0), b3, voffB); PG8_STAGE(PG8_SB(1, 1), b3 + hstep, voffB); PG8_STAGE_A(PG8_SA(1, 0), a3, 0, seln);
            PG8_WAIT_V(8); PG8_WAIT_L(0); PG8_BAR; PG8_MMA(1, 0, At, B0); PG8_MMA(1, 1, At, B1); PG8_BAR; PG8_SCHED;
            } else {
            PG8_LDB(B0, 0, 0); PG8_SCHED; PG8_LDA(At, 0, 0); PG8_STAGE(PG8_SA(1, 1), a1 + hstep, voffA);
            PG8_WAIT_L(8); PG8_BAR; PG8_WAIT_L(0); PG8_MMA(0, 0, At, B0); PG8_BAR; PG8_SCHED;
            PG8_LDB(B1, 0, 1); PG8_STAGE(PG8_SB(0, 0), b2, voffB);
            PG8_BAR; PG8_WAIT_L(0); PG8_MMA(0, 1, At, B1); PG8_BAR;
            PG8_LDA(At, 0, 1); PG8_STAGE(PG8_SA(0, 0), a2, voffA);
            PG8_BAR; PG8_WAIT_L(0); PG8_MMA(1, 0, At, B0); PG8_BAR; PG8_SCHED;
            PG8_STAGE(PG8_SB(0, 1), b2 + hstep, voffB);
            PG8_WAIT_V(6); PG8_BAR; PG8_MMA(1, 1, At, B1); PG8_BAR;
            PG8_LDB(B0, 1, 0); PG8_SCHED; PG8_LDA(At, 1, 0); PG8_STAGE(PG8_SA(0, 1), a2 + hstep, voffA);
            PG8_WAIT_L(8); PG8_BAR; PG8_WAIT_L(0); PG8_MMA(0, 0, At, B0); PG8_BAR; PG8_SCHED;
            PG8_LDB(B1, 1, 1); PG8_STAGE(PG8_SB(1, 0), b3, voffB);
            PG8_BAR; PG8_WAIT_L(0); PG8_MMA(0, 1, At, B1); PG8_BAR;
            PG8_LDA(At, 1, 1); PG8_STAGE(PG8_SA(1, 0), a3, voffA);
            PG8_BAR; PG8_WAIT_L(0); PG8_MMA(1, 0, At, B0); PG8_BAR; PG8_SCHED;
            PG8_STAGE(PG8_SB(1, 1), b3 + hstep, voffB);
            PG8_WAIT_V(6); PG8_BAR; PG8_MMA(1, 1, At, B1); PG8_BAR;
            }
        }
        if constexpr (ALIGN_EPI) { if (wr == 0) PG8_BAR; }
        if constexpr (!Epi::AFTER_DRAIN) { E(acc, cur, wr, wc, fr, fq); S.done(cur); }
        if (!has_next) break;
#pragma unroll
        for (int a = 0; a < 2; ++a)
#pragma unroll
            for (int b = 0; b < 2; ++b)
#pragma unroll
                for (int m = 0; m < 4; ++m)
#pragma unroll
                    for (int n = 0; n < 2; ++n) acc[a][b][m][n] = (f32x4){0.f, 0.f, 0.f, 0.f};
        cur = nxt; cA = nA; cB = nB; ++ui; gv[0][0] = gn[0][0]; gv[0][1] = gn[0][1]; gv[1][0] = gn[1][0]; gv[1][1] = gn[1][1];
        if constexpr (ALIGN_EPI) { if (wr == 1) PG8_BAR; }
    }
    PG8_WAIT_V(0);
    if constexpr (!ALIGN_EPI) { if (wr == 0) PG8_BAR; }
    PG8_BAR;
    if constexpr (Epi::AFTER_DRAIN) { E.fused(acc, cur, wr, wc, fr, fq, lds, wid, lane); S.done(cur); }
#undef PG8_SA
#undef PG8_SB
#undef PG8_STAGE
#undef PG8_STAGE_A
#undef PG8_ROWS
#undef PG8_LDA
#undef PG8_LDB
#undef PG8_MMA
#undef PG8_WAIT_V
#undef PG8_WAIT_L
#undef PG8_BAR
#undef PG8_SCHED
}
}
#include <hip/hip_bf16.h>
#include <cmath>
namespace attn_body {
using bf16=__hip_bfloat16;
using bf16x8=__attribute__((ext_vector_type(8)))short;
using s16x4=__attribute__((ext_vector_type(4)))short;
using f32x16=__attribute__((ext_vector_type(16)))float;
using u32x4=__attribute__((ext_vector_type(4)))unsigned;
constexpr int BATCH=4,NHEAD=32,SEQ=4096,D=64,DM=3072,DMO=2048;
constexpr int NW=8,QBLK=32,QB=QBLK*NW,KVBLK=64,NQB=SEQ/QB;
constexpr int ATTN_PITCH=DM, ATTN_UNIT_ROWS=QB;
__device__ __forceinline__ int crow(int r,int hi){return (r&3)+8*(r>>2)+4*hi;}
#define SBAR() __builtin_amdgcn_sched_barrier(0)
__device__ __forceinline__ void cmask(f32x16&p0,f32x16&p1,int jb,int qrel,int hi){
  const float NEG=-INFINITY; int kb=64*jb+4*hi;
  #pragma unroll
  for(int r=0;r<16;++r){int kv=kb+(r&3)+8*(r>>2); if(kv>qrel)p0[r]=NEG; if(kv+32>qrel)p1[r]=NEG;}
}

constexpr int NSLOT=3, SLOTB=8192;
constexpr int LDS_K=0, LDS_V=NSLOT*SLOTB, LDS_WS=2*NSLOT*SLOTB, LDS_OST=LDS_WS+NW*64*4, LDS_BYTES=LDS_OST+NW*4096;
constexpr float C2=0.125f*1.4426950408889634f;
__device__ __forceinline__ void glds16(const void*gsrc,unsigned lds_dst){unsigned keep;
  asm volatile("s_mov_b32 %0, m0\n\ts_mov_b32 m0, %2\n\ts_nop 0\n\tglobal_load_lds_dwordx4 %1, off\n\ts_mov_b32 m0, %0":"=&s"(keep):"v"(gsrc),"s"(lds_dst):"memory");}
__device__ __forceinline__ float max3f(float a,float b,float c){float r;asm("v_max3_f32 %0, %1, %2, %3":"=v"(r):"v"(a),"v"(b),"v"(c));return r;}
__device__ __forceinline__ float max2f(float a,float b){float r;asm("v_max_f32_e32 %0, %1, %2":"=v"(r):"v"(a),"v"(b));return r;}
__device__ __forceinline__ float fadd_s(float a,float b){float r;asm("v_add_f32_e32 %0, %1, %2":"=v"(r):"v"(a),"v"(b));return r;}
__device__ __forceinline__ float fsub_s(float a,float b){float r;asm("v_sub_f32_e32 %0, %1, %2":"=v"(r):"v"(a),"v"(b));return r;}
typedef float f32x2_t __attribute__((ext_vector_type(2))); typedef __bf16 bf16x2_t __attribute__((ext_vector_type(2)));
__device__ __forceinline__ unsigned cvtpk_s(float lo,float hi){f32x2_t v={lo,hi};bf16x2_t b=__builtin_convertvector(v,bf16x2_t);return __builtin_bit_cast(unsigned,b);}
#define WAIT_BAR(N) asm volatile("s_waitcnt vmcnt(" #N ") lgkmcnt(0)\n\ts_barrier":::"memory")

__device__ __forceinline__ void qkt(f32x16&p0,f32x16&p1,const char*Kslot,const bf16x8*qr,const f32x16&negm,int r32,int hi){
  const char*kb=Kslot+hi*1024+r32*16;
  #pragma unroll
  for(int d0=0;d0<4;++d0){
    const bf16x8 b0=*reinterpret_cast<const bf16x8*>(kb+d0*2048);
    const bf16x8 b1=*reinterpret_cast<const bf16x8*>(kb+d0*2048+512);
    if(d0==0){p0=__builtin_amdgcn_mfma_f32_32x32x16_bf16(b0,qr[0],negm,0,0,0);p1=__builtin_amdgcn_mfma_f32_32x32x16_bf16(b1,qr[0],negm,0,0,0);}
    else{p0=__builtin_amdgcn_mfma_f32_32x32x16_bf16(b0,qr[d0],p0,0,0,0);p1=__builtin_amdgcn_mfma_f32_32x32x16_bf16(b1,qr[d0],p1,0,0,0);}}
}
typedef __attribute__((address_space(3))) const char* lds_cptr;
typedef short v4i16_t __attribute__((ext_vector_type(4)));
__device__ __forceinline__ void kload8(bf16x8*kf,lds_cptr kp){
  kf[0]=*(const __attribute__((address_space(3))) bf16x8*)(kp);      kf[1]=*(const __attribute__((address_space(3))) bf16x8*)(kp+512);
  kf[2]=*(const __attribute__((address_space(3))) bf16x8*)(kp+2048); kf[3]=*(const __attribute__((address_space(3))) bf16x8*)(kp+2560);
  kf[4]=*(const __attribute__((address_space(3))) bf16x8*)(kp+4096); kf[5]=*(const __attribute__((address_space(3))) bf16x8*)(kp+4608);
  kf[6]=*(const __attribute__((address_space(3))) bf16x8*)(kp+6144); kf[7]=*(const __attribute__((address_space(3))) bf16x8*)(kp+6656);
}
__device__ __forceinline__ void kload2(bf16x8*kf,lds_cptr kp,int j){ kf[2*j]=*(const __attribute__((address_space(3))) bf16x8*)(kp+j*2048); kf[2*j+1]=*(const __attribute__((address_space(3))) bf16x8*)(kp+j*2048+512); }
__device__ __forceinline__ s16x4 vtr(lds_cptr p){ return __builtin_bit_cast(s16x4,__builtin_amdgcn_ds_read_tr16_b64_v4i16((__attribute__((address_space(3))) v4i16_t*)p)); }
__device__ __forceinline__ float rowmax(const f32x16&p0,const f32x16&p1){
  float a=max3f(p0[0],p0[1],p1[0]),b=max3f(p0[2],p0[3],p1[1]);a=max3f(a,p1[2],p1[3]);
  #pragma unroll
  for(int r=4;r<16;r+=4){a=max3f(a,p0[r],p0[r+1]);b=max3f(b,p0[r+2],p0[r+3]);a=max3f(a,p1[r],p1[r+1]);b=max3f(b,p1[r+2],p1[r+3]);}
  const float m=max2f(a,b);
  auto rr=__builtin_amdgcn_permlane32_swap(__float_as_uint(m),__float_as_uint(m),false,false);
  return max2f(__uint_as_float(rr[0]),__uint_as_float(rr[1]));
}
__device__ __forceinline__ void pv(f32x16*o,int vb,bf16x8 pa0,bf16x8 pa1,bf16x8 pa2,bf16x8 pa3){
  #pragma unroll
  for(int d0=0;d0<2;++d0){s16x4 lo[4],hi[4];
    #pragma unroll
    for(int ks=0;ks<4;++ks){
      asm volatile("ds_read_b64_tr_b16 %0,%1 offset:%c2":"=&v"(lo[ks]):"v"(vb),"i"(d0*4096+ks*1024):"memory");
      asm volatile("ds_read_b64_tr_b16 %0,%1 offset:%c2":"=&v"(hi[ks]):"v"(vb),"i"(d0*4096+ks*1024+512):"memory");}
    asm volatile("s_waitcnt lgkmcnt(0)":::"memory");SBAR();
    #define PK(k) (bf16x8){lo[k][0],lo[k][1],lo[k][2],lo[k][3],hi[k][0],hi[k][1],hi[k][2],hi[k][3]}
    o[d0]=__builtin_amdgcn_mfma_f32_32x32x16_bf16(pa0,PK(0),o[d0],0,0,0);
    o[d0]=__builtin_amdgcn_mfma_f32_32x32x16_bf16(pa1,PK(1),o[d0],0,0,0);
    o[d0]=__builtin_amdgcn_mfma_f32_32x32x16_bf16(pa2,PK(2),o[d0],0,0,0);
    o[d0]=__builtin_amdgcn_mfma_f32_32x32x16_bf16(pa3,PK(3),o[d0],0,0,0);
    #undef PK
  }
}

#ifndef ATTN_STORE16
#define ATTN_STORE16(p,v) (*(u32x4*)(p)=(v))
#endif
template<int THRL> __device__ __forceinline__ void attn_unit(int b,int h,int qb,const bf16*Q,const bf16*__restrict__ K,const bf16*__restrict__ V,bf16*O,char*shm){
  const int tid=threadIdx.x,lane=tid&63,r32=lane&31,hi=lane>>5; const int wid=__builtin_amdgcn_readfirstlane(tid>>6);
  const long rowbase=(long)b*SEQ; const int q0=qb*QB;
  const bf16*Qw=Q+(rowbase+q0+wid*QBLK)*DM+(h>>1)*D;
  const bf16*Kh=K+rowbase*DM+(h>>1)*D,*Vh=V+rowbase*DM+((h>>2)*2+(h&1))*D;
  const unsigned lds0=(unsigned)(uintptr_t)shm;
  float*wsf=(float*)(shm+LDS_WS)+wid*64;
  const bf16*ksrc=Kh+(long)lane*DM+wid*8;
  const bf16*vsrc=Vh+(long)(16*(wid&3)+(lane>>2))*DM+(wid>>2)*32+(lane&3)*8;
  const unsigned kdst=lds0+LDS_K+wid*1024, vdst=lds0+LDS_V+wid*1024;
  #define DMA_K(t,slot) glds16(ksrc+(long)(t)*KVBLK*DM,(unsigned)__builtin_amdgcn_readfirstlane(kdst+(slot)))
  #define DMA_V(t,slot) glds16(vsrc+(long)(t)*KVBLK*DM,(unsigned)__builtin_amdgcn_readfirstlane(vdst+(slot)))
  const int vb0=(int)(lds0+LDS_V)+((lane>>4)&1)*32+(lane&3)*8+(4*hi+((lane&15)>>2))*64;
  const char*Kbase=shm+LDS_K; bf16x8 kf[8];
  const lds_cptr shm3=(lds_cptr)shm; const lds_cptr kp0=shm3+LDS_K+hi*1024+r32*16; const lds_cptr vp0=shm3+LDS_V+((lane>>4)&1)*32+(lane&3)*8+(4*hi+((lane&15)>>2))*64;
  const int NT=(q0+QB)/KVBLK;
  DMA_K(0,0);DMA_V(0,0);DMA_K(1,SLOTB);
  bf16x8 qr[4];
  #pragma unroll
  for(int d0=0;d0<4;++d0)qr[d0]=*reinterpret_cast<const bf16x8*>(&Qw[(long)r32*DM+d0*16+hi*8]);
  float mhat=0.f,l_reg=0.f;f32x16 o[2];o[0]=f32x16{};o[1]=f32x16{};f32x16 negm=f32x16{};asm volatile("":"+v"(negm));
  const int qrel=wid*QBLK+r32;
  #define CMASK(P0,P1,t) do{int jb_=(t)-(NT-4); if(jb_>=0)cmask(P0,P1,jb_,qrel,hi);}while(0)
  bool resc=false;
  #define START(P0,P1) do{ const float rm=rowmax(P0,P1); resc=false; \
    { const float dl=rm; mhat=fadd_s(mhat,dl); \
      _Pragma("unroll") for(int r=0;r<16;++r){P0[r]=fsub_s(P0[r],dl);P1[r]=fsub_s(P1[r],dl);} \
      _Pragma("unroll") for(int r=0;r<16;++r)negm[r]=-mhat; asm volatile("":"+v"(negm)); } \
    _Pragma("unroll") for(int r=0;r<16;++r)P0[r]=__builtin_amdgcn_exp2f(P0[r]); }while(0)
  #define RESC() do{ if(resc){ asm volatile("s_waitcnt lgkmcnt(0)":::"memory"); \
      _Pragma("unroll") for(int d_=0;d_<2;++d_) _Pragma("unroll") for(int r=0;r<16;++r)o[d_][r]*=wsf[crow(r,hi)]; } }while(0)
  f32x16 pA0,pA1,pB0,pB1;
  int sl_prev=0,sl_cur=0,sl_next=SLOTB;
  #define ROT() do{sl_prev=sl_cur;sl_cur=sl_next;sl_next=(sl_next==(NSLOT-1)*SLOTB)?0:sl_next+SLOTB;}while(0)
  DMA_K(2,2*SLOTB);
  WAIT_BAR(3);
  qkt(pA0,pA1,Kbase,qr,negm,r32,hi);asm volatile("s_nop 15\n\ts_nop 7":"+v"(pA0),"+v"(pA1));CMASK(pA0,pA1,0);
  START(pA0,pA1);
  _Pragma("unroll") for(int r=0;r<16;++r)pA1[r]=__builtin_amdgcn_exp2f(pA1[r]);
  WAIT_BAR(0);
  DMA_K(3,0);DMA_V(1,SLOTB);
  ROT();
  kload8(kf,kp0+sl_cur);
  WAIT_BAR(2);
  s16x4 vlo[8],vhi[8]; u32x4 pw0,pw1,pw2,pw3;
  #define PKW(P,B) cvtpk_s(P[B],P[B+1])
  #define PAF(k) __builtin_bit_cast(bf16x8,pw##k)
  #define VFR(i) (bf16x8){vlo[i][0],vlo[i][1],vlo[i][2],vlo[i][3],vhi[i][0],vhi[i][1],vhi[i][2],vhi[i][3]}
  #define PIN(x) asm volatile("":"+v"(x))
  #define MX3(a,b,c) __builtin_fmaxf(__builtin_fmaxf((a),(b)),(c))
  #define GAPA(MF,A0,A1,A2,A3,W0,W1,PW) do{ MF; sacc+=A0; sacc+=A1; sacc+=A2; sacc+=A3; PIN(sacc); W0; W1; PIN(PW); SBAR(); }while(0)
  #define EX(v) __builtin_amdgcn_exp2f(v)
  #define GAPB(MF,X,B) do{ MF; X[B]=EX(X[B]); X[B+1]=EX(X[B+1]); X[B+2]=EX(X[B+2]); X[B+3]=EX(X[B+3]); PIN(X); SBAR(); }while(0)
  #define VRD(i) do{ vlo[i]=vtr(vp_+(((i)>>2)*4096+((i)&3)*1024)); vhi[i]=vtr(vp_+(((i)>>2)*4096+((i)&3)*1024+512)); }while(0)
  #define KRD(G,j) do{ if(G){ kload2(kf,kp0+sl_next,j); SBAR(); } }while(0)
  #define STEP(C0,C1,P0,P1,t,GK,GV,GL) do{ SBAR(); \
    const lds_cptr vp_=vp0+sl_prev; \
    VRD(0); SBAR(); float sacc=(P0[0]+P0[1]); \
    GAPA(C0=__builtin_amdgcn_mfma_f32_32x32x16_bf16(kf[0],qr[0],negm,0,0,0), P0[2],P0[3],P0[4],P0[5],     pw0[0]=PKW(P0,0), pw0[1]=PKW(P0,2), pw0); \
    VRD(4); SBAR(); GAPA(C1=__builtin_amdgcn_mfma_f32_32x32x16_bf16(kf[1],qr[0],negm,0,0,0), P0[6],P0[7],P0[8],P0[9],     pw0[2]=PKW(P0,4), pw0[3]=PKW(P0,6), pw0); \
    VRD(1); SBAR(); GAPA(C0=__builtin_amdgcn_mfma_f32_32x32x16_bf16(kf[2],qr[1],C0,0,0,0),   P0[10],P0[11],P0[12],P0[13], pw1[0]=PKW(P0,8), pw1[1]=PKW(P0,10), pw1); \
    VRD(5); SBAR(); GAPA(C1=__builtin_amdgcn_mfma_f32_32x32x16_bf16(kf[3],qr[1],C1,0,0,0),   P0[14],P0[15],P1[0],P1[1],   pw1[2]=PKW(P0,12),pw1[3]=PKW(P0,14), pw1); \
    VRD(2); SBAR(); GAPA(C0=__builtin_amdgcn_mfma_f32_32x32x16_bf16(kf[4],qr[2],C0,0,0,0),   P1[2],P1[3],P1[4],P1[5],     pw2[0]=PKW(P1,0), pw2[1]=PKW(P1,2), pw2); \
    VRD(6); SBAR(); GAPA(C1=__builtin_amdgcn_mfma_f32_32x32x16_bf16(kf[5],qr[2],C1,0,0,0),   P1[6],P1[7],P1[8],P1[9],     pw2[2]=PKW(P1,4), pw2[3]=PKW(P1,6), pw2); \
    VRD(3); SBAR(); GAPA(C0=__builtin_amdgcn_mfma_f32_32x32x16_bf16(kf[6],qr[3],C0,0,0,0),   P1[10],P1[11],P1[12],P1[13], pw3[0]=PKW(P1,8), pw3[1]=PKW(P1,10), pw3); \
    VRD(7); SBAR(); GAPA(C1=__builtin_amdgcn_mfma_f32_32x32x16_bf16(kf[7],qr[3],C1,0,0,0),   P1[14],P1[15],0.f,0.f,       pw3[2]=PKW(P1,12),pw3[3]=PKW(P1,14), pw3); \
    l_reg+=sacc; \
    if(GK){DMA_K((t)+3,sl_cur);} if(GV){DMA_V((t)+1,sl_next);} \
    CMASK(C0,C1,t); \
    { float a=MX3(C0[0],C0[1],C1[0]),b=MX3(C0[2],C0[3],C1[1]); a=MX3(a,C1[2],C1[3]); \
      _Pragma("unroll") for(int r=4;r<16;r+=4){a=MX3(a,C0[r],C0[r+1]);b=MX3(b,C0[r+2],C0[r+3]);a=MX3(a,C1[r],C1[r+1]);b=MX3(b,C1[r+2],C1[r+3]);} \
      float rm=__builtin_fmaxf(a,b); { auto rr=__builtin_amdgcn_permlane32_swap(__float_as_uint(rm),__float_as_uint(rm),false,false); rm=__builtin_fmaxf(__uint_as_float(rr[0]),__uint_as_float(rr[1])); } \
      resc=false; \
      if(__builtin_expect(__any(rm>(float)THRL),0)){ const float dl=__builtin_fmaxf(rm,0.f); mhat+=dl; \
        _Pragma("unroll") for(int r=0;r<16;++r){C0[r]-=dl;C1[r]-=dl;} \
        _Pragma("unroll") for(int r=0;r<16;++r)negm[r]=-mhat; asm volatile("":"+v"(negm)); \
        const float f=__builtin_amdgcn_exp2f(-dl); l_reg*=f; if(hi==0)wsf[r32]=f; resc=true; } } \
    SBAR(); \
    GAPB(o[0]=__builtin_amdgcn_mfma_f32_32x32x16_bf16(PAF(0),VFR(0),o[0],0,0,0), C0,0); \
    GAPB(o[1]=__builtin_amdgcn_mfma_f32_32x32x16_bf16(PAF(0),VFR(4),o[1],0,0,0), C0,4); \
    KRD(GL,0); GAPB(o[0]=__builtin_amdgcn_mfma_f32_32x32x16_bf16(PAF(1),VFR(1),o[0],0,0,0), C0,8); \
    KRD(GL,1); GAPB(o[1]=__builtin_amdgcn_mfma_f32_32x32x16_bf16(PAF(1),VFR(5),o[1],0,0,0), C0,12); \
    KRD(GL,2); GAPB(o[0]=__builtin_amdgcn_mfma_f32_32x32x16_bf16(PAF(2),VFR(2),o[0],0,0,0), C1,0); \
    KRD(GL,3); GAPB(o[1]=__builtin_amdgcn_mfma_f32_32x32x16_bf16(PAF(2),VFR(6),o[1],0,0,0), C1,4); \
    GAPB(o[0]=__builtin_amdgcn_mfma_f32_32x32x16_bf16(PAF(3),VFR(3),o[0],0,0,0), C1,8); \
    GAPB(o[1]=__builtin_amdgcn_mfma_f32_32x32x16_bf16(PAF(3),VFR(7),o[1],0,0,0), C1,12); \
    }while(0)
  int t=1;
  #undef CMASK
  #define CMASK(P0,P1,t) do{}while(0)
  for(;t+5<NT;t+=2){
    STEP(pB0,pB1,pA0,pA1,t,true,true,true);     WAIT_BAR(2); RESC(); ROT();
    STEP(pA0,pA1,pB0,pB1,t+1,true,true,true);   WAIT_BAR(2); RESC(); ROT();
  }
  #undef CMASK
  #define CMASK(P0,P1,t) do{int jb_=(t)-(NT-4); if(jb_>=0)cmask(P0,P1,jb_,qrel,hi);}while(0)
  #define ENDW(tt) do{ if((tt)+3<NT){WAIT_BAR(2);} else if((tt)+2<NT){WAIT_BAR(1);} else {WAIT_BAR(0);} }while(0)
  for(;t+1<NT;t+=2){
    STEP(pB0,pB1,pA0,pA1,t,(t+3<NT),(t+1<NT),(t+1<NT));       ENDW(t);   RESC(); ROT();
    STEP(pA0,pA1,pB0,pB1,t+1,(t+4<NT),(t+2<NT),(t+2<NT));     ENDW(t+1); RESC(); ROT();
  }
  STEP(pB0,pB1,pA0,pA1,NT-1,false,false,false); RESC();
  { float sacc=pB0[0]+pB0[1]; _Pragma("unroll") for(int r=2;r<16;++r)sacc+=pB0[r]; _Pragma("unroll") for(int r=0;r<16;++r)sacc+=pB1[r]; l_reg+=sacc;
    pw0=(u32x4){PKW(pB0,0),PKW(pB0,2),PKW(pB0,4),PKW(pB0,6)};pw1=(u32x4){PKW(pB0,8),PKW(pB0,10),PKW(pB0,12),PKW(pB0,14)};pw2=(u32x4){PKW(pB1,0),PKW(pB1,2),PKW(pB1,4),PKW(pB1,6)};pw3=(u32x4){PKW(pB1,8),PKW(pB1,10),PKW(pB1,12),PKW(pB1,14)};
    SBAR(); pv(o,vb0+sl_cur,PAF(0),PAF(1),PAF(2),PAF(3)); }
  #undef PKW
  #undef PAF
  #undef VFR
  #undef PIN
  #undef MX3
  #undef GAPA
  #undef GAPB
  #undef EX
  #undef VRD
  #undef KRD
  #undef STEP
  #undef ENDW
  {auto rr=__builtin_amdgcn_permlane32_swap(__float_as_uint(l_reg),__float_as_uint(l_reg),false,false);l_reg=__uint_as_float(rr[0])+__uint_as_float(rr[1]);}
  if(hi==0)wsf[32+r32]=l_reg;asm volatile("s_waitcnt lgkmcnt(0)":::"memory");
  float rli[16];
  #pragma unroll
  for(int r=0;r<16;++r)rli[r]=__builtin_amdgcn_rcpf(wsf[32+crow(r,hi)]);
  bf16*Ow=O+(rowbase+q0+wid*QBLK)*DMO+h*D;
  { bf16*stg=(bf16*)(shm+LDS_OST)+wid*2048;
    #pragma unroll
    for(int r=0;r<16;++r){const int orow=crow(r,hi);
      #pragma unroll
      for(int d0=0;d0<2;++d0)stg[orow*64+d0*32+r32]=__float2bfloat16(o[d0][r]*rli[r]);}
    asm volatile("s_waitcnt lgkmcnt(0)":::"memory");
    #pragma unroll
    for(int i=0;i<4;++i){const int row=i*8+(lane>>3),ch=lane&7; const u32x4 v=*(const u32x4*)(stg+row*64+ch*8); ATTN_STORE16(Ow+(long)row*DMO+ch*8,v);} }
  asm volatile("s_waitcnt lgkmcnt(0)\n\ts_barrier":::"memory");
  #undef DMA_K
  #undef DMA_V
  #undef CMASK
  #undef START
  #undef RESC
  #undef ROT
}
constexpr int ATTN_LDS_BYTES=LDS_BYTES;
struct AttnTensors { const bf16* Q; const bf16* K; const bf16* V; bf16* O; };
struct AttnUnit { int bh; int qb; };
struct StaticOrder {
  int vcu;
  __device__ __forceinline__ explicit StaticOrder(int grid,int block):vcu((grid%8==0)?((block%8)*(grid/8)+block/8):block){}
  __device__ __forceinline__ bool next(int i,AttnUnit&u)const{ if(i>=8)return false; const int s=4*(vcu&1)+(i>>1); u.bh=vcu>>1; u.qb=(i&1)?15-s:s; return true; }
  __device__ __forceinline__ void a_ready(const AttnUnit&)const{}
  __device__ __forceinline__ void done(const AttnUnit&)const{}
};
template<class Sched,int THRL=8> __device__ __forceinline__ void attn_phase(char*lds,const AttnTensors&T,const Sched&S){
  AttnUnit u;
  for(int i=0;S.next(i,u);++i){ S.a_ready(u); attn_unit<THRL>(u.bh/NHEAD,u.bh%NHEAD,u.qb,T.Q,T.K,T.V,T.O,lds); S.done(u); }
}
#undef SBAR
#undef WAIT_BAR
}
namespace {
typedef short bf16x8_t __attribute__((ext_vector_type(8)));
typedef float f32x16_t __attribute__((ext_vector_type(16)));
typedef float f32x4_t __attribute__((ext_vector_type(4)));
typedef float f32x2_t __attribute__((ext_vector_type(2)));

constexpr size_t MiB = 1u << 20;
constexpr size_t WS_CTL = 0, CTL_ZERO_BYTES = 1 * MiB;
constexpr size_t WS_WIN = 1 * MiB;
constexpr size_t WS_WOUT = 6 * MiB;
constexpr size_t WS_WQKV = 8 * MiB;
constexpr size_t WS_CWOUT = 14 * MiB;
constexpr size_t WS_SMALLW = 16 * MiB;
constexpr size_t WS_MISC = 17 * MiB;
constexpr size_t WS_XN = 19 * MiB;
constexpr size_t WS_BIG = 51 * MiB;
constexpr size_t WS_W1T = 147 * MiB;
constexpr size_t WS_W2T = 275 * MiB;
constexpr size_t WS_R3 = 339 * MiB;
constexpr size_t WS_Y = 459 * MiB;
constexpr size_t WS_G = 491 * MiB;
constexpr size_t WS_END = 507 * MiB;
constexpr int CW_MOE0 = 0, CW_MOE1 = 4096, CW_BAR = 8192;
constexpr int MOE_PLAN = 2048;
constexpr int LDS_BYTES = 155648;
constexpr int MISC_OFF = 151552;

#define XB_TMO      128
#define XB_XCNT(j)  (256  + 64 * (j))
#define XB_XSUB(j)  (1280 + 64 * (j))
#define XB_XGEN(j)  (2304 + 64 * (j))
#define XB_TOP      3328
#define XB_TOPGEN   3392
#define XCD_BAR_WORDS 3456
#define XB_SPIN_CAP (1u << 18)

__device__ __forceinline__ unsigned xb_ld(unsigned* p)              { return __hip_atomic_load(p, __ATOMIC_RELAXED, __HIP_MEMORY_SCOPE_AGENT); }
__device__ __forceinline__ unsigned xb_add(unsigned* p, unsigned v) { return __hip_atomic_fetch_add(p, v, __ATOMIC_RELAXED, __HIP_MEMORY_SCOPE_AGENT); }
__device__ __forceinline__ unsigned xb_xcc_id() { return (unsigned)__builtin_amdgcn_s_getreg((3 << 11) | 20) & 0xFu; }
#define XB_SPIN(cond, bar) do { unsigned _sp = 0; while (cond) { __builtin_amdgcn_s_sleep(1); \
    if ((++_sp & 255u) == 0u) { if (xb_ld(&(bar)[XB_TMO])) break; if (_sp > XB_SPIN_CAP) { atomicAdd(&(bar)[XB_TMO], 1u); break; } } } } while (0)

struct XcdBarrier {
    unsigned* bar; unsigned x;
    volatile LAS unsigned* st;
};

__device__ __forceinline__ XcdBarrier xcd_barrier_post(unsigned* bar, volatile LAS unsigned* st) {
    XcdBarrier b; b.bar = bar; b.x = xb_xcc_id(); b.st = st;
    if (threadIdx.x == 0) (void)xb_add(&bar[XB_XCNT(b.x)], 1u);
    return b;
}
__device__ __forceinline__ void xcd_barrier_complete(unsigned* bar, unsigned x, unsigned& nloc, unsigned& nx) {
    const unsigned G = gridDim.x * gridDim.y * gridDim.z;
    unsigned sum, cnt, mine, sp = 0u;
    for (;;) {
        sum = 0u; cnt = 0u; mine = 0u;
#pragma unroll
        for (unsigned j = 0; j < 16; ++j) { const unsigned c = xb_ld(&bar[XB_XCNT(j)]); sum += c; cnt += (c > 0u) ? 1u : 0u; mine = (j == x) ? c : mine; }
        if (sum == G) break;
        __builtin_amdgcn_s_sleep(1);
        if ((++sp & 255u) == 0u) { if (xb_ld(&bar[XB_TMO])) break; if (sp > XB_SPIN_CAP) { atomicAdd(&bar[XB_TMO], 1u); break; } }
    }
    nloc = mine > 0u ? mine : 1u; nx = cnt > 0u ? cnt : 1u;
}

__device__ __forceinline__ void xcd_barrier(const XcdBarrier& b) {
    asm volatile("s_waitcnt vmcnt(0)" ::: "memory");
    __syncthreads();
    if (threadIdx.x == 0) {
        unsigned* bar = b.bar;
        __builtin_amdgcn_s_waitcnt(0);
        unsigned nloc = b.st[0], nx = b.st[1];
        if (nloc == 0u) { xcd_barrier_complete(bar, b.x, nloc, nx); b.st[0] = nloc; b.st[1] = nx; }
        const unsigned old = xb_add(&bar[XB_XSUB(b.x)], 1u);
        const unsigned gen = old / nloc;
        if (old + 1u == (gen + 1u) * nloc) {
            __builtin_amdgcn_fence(__ATOMIC_RELEASE, "agent");
            asm volatile("s_waitcnt vmcnt(0)" ::: "memory");
            const unsigned og = xb_add(&bar[XB_TOP], 1u);
            const unsigned tg = og / nx;
            if (og + 1u == (tg + 1u) * nx) xb_add(&bar[XB_TOPGEN], 1u);
            else XB_SPIN(xb_ld(&bar[XB_TOPGEN]) == tg, bar);
            __builtin_amdgcn_fence(__ATOMIC_ACQUIRE, "agent");
            xb_add(&bar[XB_XGEN(b.x)], 1u);
            asm volatile("s_waitcnt vmcnt(0)" ::: "memory");
        } else {
            XB_SPIN(xb_ld(&bar[XB_XGEN(b.x)]) == gen, bar);
            __builtin_amdgcn_fence(__ATOMIC_ACQUIRE, "agent");
            asm volatile("s_waitcnt vmcnt(0)" ::: "memory");
        }
    }
    __syncthreads();
}


struct Params { const float* in[33]; float* out; unsigned char* ws; int ph_lo, ph_hi; };
struct Frame { LAS unsigned char* lds; int tid, lane, wave, vcu, G; };

template <int CTRL, int RMASK> __device__ __forceinline__ float dpp_f(float x) {
    return __builtin_bit_cast(float, __builtin_amdgcn_update_dpp(0, __builtin_bit_cast(int, x), CTRL, RMASK, 0xf, false));
}
__device__ __forceinline__ float wsum(float x) {
    x += dpp_f<0xB1, 0xf>(x);
    x += dpp_f<0x4E, 0xf>(x);
    x += dpp_f<0x141, 0xf>(x);
    x += dpp_f<0x140, 0xf>(x);
    x += dpp_f<0x142, 0xa>(x);
    x += dpp_f<0x143, 0xc>(x);
    return __builtin_bit_cast(float, __builtin_amdgcn_readlane(__builtin_bit_cast(int, x), 63));
}
__device__ __forceinline__ int crow(int r, int hi) { return (r & 3) + 8 * (r >> 2) + 4 * hi; }
__device__ __forceinline__ float fsigmoid(float x) { return __builtin_amdgcn_rcpf(1.f + __builtin_amdgcn_exp2f(-1.4426950408889634f * x)); }
__device__ __forceinline__ float ftanh(float x) { return 2.f * fsigmoid(2.f * x) - 1.f; }

struct TItem { const float* W; bf16_t* WT; int ldw, ldt, k0, n0, drow0; };
__device__ __forceinline__ void ti_load(const TItem& t, float (&v)[32], int lane) {
#pragma unroll
    for (int i = 0; i < 32; ++i) v[i] = t.W[(size_t)(t.k0 + 2 * i + (lane >> 5)) * t.ldw + t.n0 + (lane & 31)];
}
__device__ __forceinline__ void ti_store(const TItem& t, const float (&v)[32], LAS float* scr, int lane) {
#pragma unroll
    for (int i = 0; i < 32; ++i) scr[(2 * i + (lane >> 5)) * 33 + (lane & 31)] = v[i];
    asm volatile("s_waitcnt lgkmcnt(0)" ::: "memory");
    const int c = lane & 7;
#pragma unroll
    for (int j = 0; j < 4; ++j) { const int n = (lane >> 3) + 8 * j; const LAS float* s = scr + (8 * c) * 33 + n;
        u32x4_t o; o.x = pk2(s[0 * 33], s[1 * 33]); o.y = pk2(s[2 * 33], s[3 * 33]); o.z = pk2(s[4 * 33], s[5 * 33]); o.w = pk2(s[6 * 33], s[7 * 33]);
        *(u32x4_t*)(t.WT + (size_t)(t.drow0 + n) * t.ldt + t.k0 + 8 * c) = o; }
    asm volatile("s_waitcnt lgkmcnt(0)" ::: "memory");
}
__device__ __forceinline__ void transpose_item(const float* W, int ldw, bf16_t* WT, int ldt, int k0, int n0, int drow0, LAS float* scr, int lane) {
    const TItem t{W, WT, ldw, ldt, k0, n0, drow0}; float v[32]; ti_load(t, v, lane); ti_store(t, v, scr, lane);
}
constexpr int IT_IN = 16 * 72, IT_OUT = 16 * 32, IT_QKV = 16 * 96, IT_DENSE = IT_IN + 2 * IT_OUT + IT_QKV;
constexpr int IT_GU = 16 * 16, IT_DN = 8 * 32, IT_EXP = 2 * IT_GU + IT_DN;
__device__ __forceinline__ void conv_dense_item(const Params& P, int it, LAS float* scr, int lane) {
    unsigned char* ws = P.ws;
    if (it < IT_IN) { const int kb = it / 72, nb = it % 72; transpose_item(P.in[4], INW, (bf16_t*)(ws + WS_WIN), D, kb * 64, nb * 32, nb * 32, scr, lane); return; } it -= IT_IN;
    if (it < IT_OUT) { const int kb = it / 32, nb = it % 32; transpose_item(P.in[18], D, (bf16_t*)(ws + WS_WOUT), D, kb * 64, nb * 32, nb * 32, scr, lane); return; } it -= IT_OUT;
    if (it < IT_QKV) { const int kb = it / 96, nb = it % 96; transpose_item(P.in[19], QKVW, (bf16_t*)(ws + WS_WQKV), D, kb * 64, nb * 32, nb * 32, scr, lane); return; } it -= IT_QKV;
    { const int kb = it / 32, nb = it % 32; transpose_item(P.in[25], D, (bf16_t*)(ws + WS_CWOUT), D, kb * 64, nb * 32, nb * 32, scr, lane); }
}
__device__ __forceinline__ TItem moe_item(const Params& P, int it) {
    const int le = it / IT_EXP; int r = it % IT_EXP;
    if (r < 2 * IT_GU) {
        const int isup = r / IT_GU; r %= IT_GU; const int kb = r / 16, nb = r % 16, n0 = nb * 32;
        const float* W = (isup ? P.in[31] : P.in[30]) + (size_t)le * D * MH;
        return TItem{W, (bf16_t*)(P.ws + WS_W1T) + (size_t)le * 1024 * D, MH, D, kb * 64, n0, (n0 / 128) * 256 + isup * 128 + (n0 % 128)};
    }
    r -= 2 * IT_GU; const int kb = r / 32, nb = r % 32;
    return TItem{P.in[32] + (size_t)le * MH * D, (bf16_t*)(P.ws + WS_W2T) + (size_t)le * D * MH, D, MH, kb * 64, nb * 32, nb * 32};
}
__device__ __forceinline__ void conv_moe_all(const Params& P, int cw, int NCW, LAS float* scr, int lane) {
    float va[32], vb[32];
    int it = cw;
    if (it >= 64 * IT_EXP) return;
    TItem ta = moe_item(P, it), tb = ta;
    ti_load(ta, va, lane);
#pragma unroll 1
    for (;;) {
        const int itb = it + NCW; const bool hb = itb < 64 * IT_EXP;
        if (hb) { tb = moe_item(P, itb); ti_load(tb, vb, lane); }
        ti_store(ta, va, scr, lane);
        if (!hb) break;
        const int ita = itb + NCW; const bool ha = ita < 64 * IT_EXP;
        if (ha) { ta = moe_item(P, ita); ti_load(ta, va, lane); }
        ti_store(tb, vb, scr, lane);
        if (!ha) break;
        it = ita;
    }
}
__device__ __forceinline__ void rms_row_to_bf16(const float* xrow, const float* g, bf16_t* orow, int lane) {
    const f32x4_t* xr = (const f32x4_t*)xrow + lane; const f32x4_t* gr = (const f32x4_t*)g + lane;
    f32x4_t v[4]; float s = 0.f;
#pragma unroll
    for (int j = 0; j < 4; ++j) { v[j] = xr[64 * j]; s += (v[j].x * v[j].x + v[j].y * v[j].y) + (v[j].z * v[j].z + v[j].w * v[j].w); }
    const float rs = rsqrtf(wsum(s) * (1.f / D) + 1e-6f);
    u32x2_t* o8 = (u32x2_t*)orow + lane;
#pragma unroll
    for (int j = 0; j < 4; ++j) { const f32x4_t gg = gr[64 * j]; u32x2_t o; o.x = pk2(v[j].x * rs * gg.x, v[j].y * rs * gg.y); o.y = pk2(v[j].z * rs * gg.z, v[j].w * rs * gg.w); o8[64 * j] = o; }
}

__device__ __forceinline__ void ph_prologue(const Frame& F, const Params& P) {
    LAS float* scr = (LAS float*)(F.lds + F.wave * 16384);
    const int gw = F.vcu * 8 + F.wave, NGW = F.G * 8;
    for (int it = gw; it < IT_DENSE; it += NGW) conv_dense_item(P, it, scr, F.lane);
    bf16_t* w2p = (bf16_t*)(P.ws + WS_SMALLW); bf16_t* a2p = w2p + 32768; bf16_t* g2p = a2p + 32768; bf16_t* wpp = g2p + 65536; float* cs = (float*)(wpp + 65536);
    const int gt = F.vcu * 512 + F.tid, NGT = F.G * 512;
    for (int idx = gt; idx < 32768; idx += NGT) {
        const int row = idx >> 6, k = idx & 63, hd = row >> 6, nt = (row >> 5) & 1, c = row & 31, col = hd * 64 + 2 * c + nt;
        w2p[idx] = (bf16_t)f2bf(P.in[7][k * RW + col]); a2p[idx] = (bf16_t)f2bf(P.in[9][k * RW + col]);
    }
    for (int idx = gt; idx < 65536; idx += NGT) {
        { const int row = idx >> 7, k = idx & 127, hd = row >> 6, nt = (row >> 5) & 1, c = row & 31, col = hd * 64 + 2 * c + nt; g2p[idx] = (bf16_t)f2bf(P.in[10][k * RW + col]); }
        { const int gi = idx >> 14, row = (idx >> 7) & 127, k = idx & 127, nh = row >> 6, nt = (row >> 5) & 1, c = row & 31, n = nh * 64 + 2 * c + nt;
          wpp[idx] = (bf16_t)f2bf(P.in[16][(size_t)gi * 16384 + k * 128 + n]); }
    }
    {
        bf16_t* rw = (bf16_t*)(P.ws + WS_MISC + MiB);
        for (int idx = gt; idx < 2 * 65536; idx += NGT) {
            const int layer = idx >> 16, j = (idx >> 10) & 63, k = idx & 1023;
            float w = 0.f;
            if (j < 4) w = P.in[26][(size_t)layer * D * 4 + k * 4 + j]; else if (j < 36) w = P.in[28][(size_t)layer * D * 32 + k * 32 + (j - 4)];
            w *= P.in[2][layer * D + k];
            const unsigned h = f2bf(w); const float hf = __builtin_bit_cast(float, h << 16);
            rw[(size_t)layer * 131072 + j * 1024 + k] = (bf16_t)h; rw[(size_t)layer * 131072 + 65536 + j * 1024 + k] = (bf16_t)f2bf(w - hf);
        }
    }
    for (int i = gt; i < SEQ * 8; i += NGT) {
        const int t = i >> 3, f = i & 7;
        const double inv = exp(-log(500000.0) * (double)f / 8.0), ang = (double)t * inv;
        cs[i * 2] = (float)cos(ang); cs[i * 2 + 1] = (float)sin(ang);
    }
    for (int m = gw; m < NTOK; m += NGW) rms_row_to_bf16(P.in[0] + (size_t)m * D, P.in[1], (bf16_t*)(P.ws + WS_XN) + (size_t)m * D, F.lane);
}

__device__ __forceinline__ void ph_prep(const Frame& F, const Params& P) {
    const bf16_t* p = (const bf16_t*)(P.ws + WS_BIG);
    const float* mu = P.in[5]; const float* w0 = P.in[6]; const float* a0 = P.in[8]; const float* k_k = P.in[11]; const float* k_a = P.in[12]; const float* pool_scale = P.in[17];
    const bf16_t* w2p = (const bf16_t*)(P.ws + WS_SMALLW); const bf16_t* a2p = w2p + 32768; const bf16_t* g2p = a2p + 32768; const bf16_t* wpp = g2p + 65536;
    float* Wd = (float*)(P.ws + WS_R3);
    bf16_t* Rb = (bf16_t*)(P.ws + WS_R3 + 32 * MiB); bf16_t* Kb = Rb + (size_t)NTOK * RW; bf16_t* KKb = Kb + (size_t)NTOK * RW; bf16_t* Bb = KKb + (size_t)NTOK * RW; bf16_t* Vb = Bb + (size_t)NTOK * RW;
    bf16_t* Gb = (bf16_t*)(P.ws + WS_G); bf16_t* XN = (bf16_t*)(P.ws + WS_XN);
    LAS unsigned char* lora = F.lds; LAS unsigned char* poold = F.lds + 32 * 528;
    const int tid = F.tid, lane = F.lane, r32 = lane & 31, hi = lane >> 5, hd = F.wave;
    for (int unit = F.vcu; unit < NTOK / 32; unit += F.G) {
        const int tok0 = unit * 32, t0 = tok0 % SEQ;
        {
            const int tl = tid >> 4, c0 = (tid & 15) * 16, t = t0 + tl;
            const bf16_t* pc = p + (size_t)(tok0 + tl) * INW + 1536 + c0;
            u32x4_t cu[2], pv[2];
            cu[0] = *(const u32x4_t*)pc; cu[1] = *(const u32x4_t*)(pc + 8);
            if (t > 0) { pv[0] = *(const u32x4_t*)(pc - INW); pv[1] = *(const u32x4_t*)(pc - INW + 8); } else { pv[0] = (u32x4_t){0, 0, 0, 0}; pv[1] = pv[0]; }
            u32x4_t ov[2];
#pragma unroll
            for (int h2 = 0; h2 < 2; ++h2) {
#pragma unroll
                for (int q = 0; q < 4; ++q) {
                    const f32x2_t m2 = *(const f32x2_t*)(mu + 1536 + c0 + h2 * 8 + q * 2);
                    const float c_lo = bflo(cu[h2][q]), c_hi = bfhi(cu[h2][q]), p_lo = bflo(pv[h2][q]), p_hi = bfhi(pv[h2][q]);
                    float z0 = c_lo + (p_lo - c_lo) * m2.x, z1 = c_hi + (p_hi - c_hi) * m2.y;
                    if (c0 < 64) { z0 = ftanh(z0); z1 = ftanh(z1); } else if (c0 >= 128) { z0 = fsigmoid(z0); z1 = fsigmoid(z1); }
                    ov[h2][q] = pk2(z0, z1);
                }
            }
            *(LAS u32x4_t*)(lora + tl * 528 + c0 * 2) = ov[0]; *(LAS u32x4_t*)(lora + tl * 528 + c0 * 2 + 16) = ov[1];
        }
        {
            const int c = tid, gi = c >> 7, win = 2 << gi;
            const bf16_t* pu = p + (size_t)tok0 * INW + SHIFTW + c;
            float s = 0.f;
            for (int q = 1; q < win; ++q) if (t0 - q >= 0) s += bf2f(pu[-(ptrdiff_t)q * INW]);
            for (int tl = 0; tl < 32; ++tl) {
                const int t = t0 + tl; const float u = bf2f(pu[(ptrdiff_t)tl * INW]);
                s += u;
                const int cnt = (t + 1 < win) ? (t + 1) : win;
                *(LAS bf16_t*)(poold + tl * 1040 + c * 2) = (bf16_t)f2bf(s / (float)cnt - u);
                if (t - win + 1 >= 0) s -= bf2f(pu[(ptrdiff_t)(tl - win + 1) * INW]);
            }
        }
        __syncthreads();
        const int ch = hd * 64 + 2 * r32;
        const LAS unsigned char* arow = lora + r32 * 528 + hi * 16;
        {
            f32x16_t acc0 = {}, acc1 = {};
#pragma unroll
            for (int ks = 0; ks < 8; ++ks) {
                const bf16x8_t a = *(const LAS bf16x8_t*)(arow + (128 + ks * 16) * 2);
                const bf16x8_t b0 = *(const bf16x8_t*)(g2p + (size_t)(hd * 64 + r32) * 128 + ks * 16 + hi * 8);
                const bf16x8_t b1 = *(const bf16x8_t*)(g2p + (size_t)(hd * 64 + 32 + r32) * 128 + ks * 16 + hi * 8);
                acc0 = __builtin_amdgcn_mfma_f32_32x32x16_bf16(a, b0, acc0, 0, 0, 0); acc1 = __builtin_amdgcn_mfma_f32_32x32x16_bf16(a, b1, acc1, 0, 0, 0);
            }
#pragma unroll
            for (int r = 0; r < 16; ++r) *(unsigned*)(Gb + (size_t)(tok0 + crow(r, hi)) * RW + ch) = pk2(acc0[r], acc1[r]);
        }
        {
            f32x16_t acc0 = {}, acc1 = {};
#pragma unroll
            for (int ks = 0; ks < 4; ++ks) {
                const bf16x8_t a = *(const LAS bf16x8_t*)(arow + (ks * 16) * 2);
                const bf16x8_t b0 = *(const bf16x8_t*)(w2p + (size_t)(hd * 64 + r32) * 64 + ks * 16 + hi * 8);
                const bf16x8_t b1 = *(const bf16x8_t*)(w2p + (size_t)(hd * 64 + 32 + r32) * 64 + ks * 16 + hi * 8);
                acc0 = __builtin_amdgcn_mfma_f32_32x32x16_bf16(a, b0, acc0, 0, 0, 0); acc1 = __builtin_amdgcn_mfma_f32_32x32x16_bf16(a, b1, acc1, 0, 0, 0);
            }
            const f32x2_t w0p = *(const f32x2_t*)(w0 + ch);
#pragma unroll
            for (int r = 0; r < 16; ++r) {
                f32x2_t dv;
                dv.x = -0.6065306597126334f * fsigmoid(w0p.x + acc0[r]);
                dv.y = -0.6065306597126334f * fsigmoid(w0p.y + acc1[r]);
                *(f32x2_t*)(Wd + (size_t)(tok0 + crow(r, hi)) * RW + ch) = dv;
            }
        }
        {
            f32x16_t acc0 = {}, acc1 = {};
#pragma unroll
            for (int ks = 0; ks < 4; ++ks) {
                const bf16x8_t a = *(const LAS bf16x8_t*)(arow + (64 + ks * 16) * 2);
                const bf16x8_t b0 = *(const bf16x8_t*)(a2p + (size_t)(hd * 64 + r32) * 64 + ks * 16 + hi * 8);
                const bf16x8_t b1 = *(const bf16x8_t*)(a2p + (size_t)(hd * 64 + 32 + r32) * 64 + ks * 16 + hi * 8);
                acc0 = __builtin_amdgcn_mfma_f32_32x32x16_bf16(a, b0, acc0, 0, 0, 0); acc1 = __builtin_amdgcn_mfma_f32_32x32x16_bf16(a, b1, acc1, 0, 0, 0);
            }
            const f32x2_t a0p = *(const f32x2_t*)(a0 + ch), kkp = *(const f32x2_t*)(k_k + ch), kap = *(const f32x2_t*)(k_a + ch);
            const f32x2_t mur = *(const f32x2_t*)(mu + ch), muk = *(const f32x2_t*)(mu + 512 + ch), muv = *(const f32x2_t*)(mu + 1024 + ch);
#pragma unroll
            for (int r = 0; r < 16; ++r) {
                const int row = crow(r, hi), t = t0 + row; const size_t tok = (size_t)(tok0 + row);
                const bf16_t* pc = p + tok * INW + ch;
                const unsigned cr = *(const unsigned*)pc, ck = *(const unsigned*)(pc + 512), cv = *(const unsigned*)(pc + 1024);
                unsigned qr = 0, qk = 0, qv = 0;
                if (t > 0) { qr = *(const unsigned*)(pc - INW); qk = *(const unsigned*)(pc - INW + 512); qv = *(const unsigned*)(pc - INW + 1024); }
                const float r0 = bflo(cr) + (bflo(qr) - bflo(cr)) * mur.x, r1 = bfhi(cr) + (bfhi(qr) - bfhi(cr)) * mur.y;
                const float k0 = bflo(ck) + (bflo(qk) - bflo(ck)) * muk.x, k1 = bfhi(ck) + (bfhi(qk) - bfhi(ck)) * muk.y;
                const float v0 = bflo(cv) + (bflo(qv) - bflo(cv)) * muv.x, v1 = bfhi(cv) + (bfhi(qv) - bfhi(cv)) * muv.y;
                const float av0 = fsigmoid(a0p.x + acc0[r]), av1 = fsigmoid(a0p.y + acc1[r]);
                float kk0 = k0 * kkp.x, kk1 = k1 * kkp.y;
                float ss = kk0 * kk0 + kk1 * kk1;
#pragma unroll
                for (int o = 1; o < 32; o <<= 1) ss += __shfl_xor(ss, o);
                const float inv = 1.f / fmaxf(sqrtf(ss), 1e-12f);
                kk0 *= inv; kk1 *= inv;
                const size_t o = tok * RW + ch;
                *(unsigned*)(Rb + o) = pk2(r0, r1);
                *(unsigned*)(Kb + o) = pk2(k0 * (1.f + (av0 - 1.f) * kap.x), k1 * (1.f + (av1 - 1.f) * kap.y));
                *(unsigned*)(Vb + o) = pk2(v0, v1);
                *(unsigned*)(KKb + o) = pk2(kk0, kk1);
                *(unsigned*)(Bb + o) = pk2(kk0 * av0, kk1 * av1);
            }
        }
        {
            const int gi = F.wave >> 1, nh = F.wave & 1;
            const LAS unsigned char* prow = poold + r32 * 1040 + (gi * 128 + hi * 8) * 2;
            f32x16_t acc0 = {}, acc1 = {};
#pragma unroll
            for (int ks = 0; ks < 8; ++ks) {
                const bf16x8_t a = *(const LAS bf16x8_t*)(prow + ks * 32);
                const bf16x8_t b0 = *(const bf16x8_t*)(wpp + (size_t)(gi * 128 + nh * 64 + r32) * 128 + ks * 16 + hi * 8);
                const bf16x8_t b1 = *(const bf16x8_t*)(wpp + (size_t)(gi * 128 + nh * 64 + 32 + r32) * 128 + ks * 16 + hi * 8);
                acc0 = __builtin_amdgcn_mfma_f32_32x32x16_bf16(a, b0, acc0, 0, 0, 0); acc1 = __builtin_amdgcn_mfma_f32_32x32x16_bf16(a, b1, acc1, 0, 0, 0);
            }
            const int n = gi * 128 + nh * 64 + 2 * r32;
            const f32x2_t ps = *(const f32x2_t*)(pool_scale + n);
#pragma unroll
            for (int r = 0; r < 16; ++r) *(unsigned*)(XN + (size_t)(tok0 + crow(r, hi)) * D + RW + n) = pk2(acc0[r] * ps.x, acc1[r] * ps.y);
        }
        __syncthreads();
    }
}

constexpr int CB = 9216, CRS = 144;
constexpr size_t CH_UNIT_BYTES = 49152;
__device__ __forceinline__ f32x16_t tile_mm(const LAS unsigned char* A, int r0, const LAS unsigned char* Bt, int c0, f32x16_t acc, int r32, int hi) {
#pragma unroll
    for (int ks = 0; ks < 4; ++ks) {
        const bf16x8_t a = *(const LAS bf16x8_t*)(A + (r0 + r32) * CRS + ks * 32 + hi * 16);
        const bf16x8_t b = *(const LAS bf16x8_t*)(Bt + (c0 + r32) * CRS + ks * 32 + hi * 16);
        acc = __builtin_amdgcn_mfma_f32_32x32x16_bf16(a, b, acc, 0, 0, 0);
    }
    return acc;
}
__device__ __forceinline__ void put_rm(LAS unsigned char* buf, const f32x16_t& v, int r0, int c0, int r32, int hi) {
#pragma unroll
    for (int r = 0; r < 16; ++r) *(LAS bf16_t*)(buf + (r0 + crow(r, hi)) * CRS + (c0 + r32) * 2) = (bf16_t)f2bf(v[r]);
}
__device__ __forceinline__ void put_tr(LAS unsigned char* buf, const f32x16_t& v, int r0, int c0, int r32, int hi, float sgn) {
#pragma unroll
    for (int g = 0; g < 4; ++g) { u32x2_t w; w.x = pk2(sgn * v[4 * g], sgn * v[4 * g + 1]); w.y = pk2(sgn * v[4 * g + 2], sgn * v[4 * g + 3]);
        *(LAS u32x2_t*)(buf + (c0 + r32) * CRS + (r0 + 8 * g + 4 * hi) * 2) = w; }
}
__device__ __forceinline__ void ph_chunkA(const Frame& F, const Params& P) {
    const float* Lw = (const float*)(P.ws + WS_R3);
    const bf16_t* Rb = (const bf16_t*)(P.ws + WS_R3 + 32 * MiB); const bf16_t* Kb = Rb + (size_t)NTOK * RW; const bf16_t* KKb = Kb + (size_t)NTOK * RW; const bf16_t* Bb = KKb + (size_t)NTOK * RW; const bf16_t* Vb = Bb + (size_t)NTOK * RW;
    const int tid = F.tid, lane = F.lane, r32 = lane & 31, hi = lane >> 5, wave = F.wave;
    LAS unsigned char* L = F.lds;
#define SL(n) (L + (n) * CB)
    LAS unsigned char* s_khat = SL(0); LAS unsigned char* s_bhat = SL(1); LAS unsigned char* s_ktil = SL(2); LAS unsigned char* s_rtil = SL(3); LAS unsigned char* s_kbar = SL(4);
    LAS unsigned char* s_ktilT = SL(5); LAS unsigned char* s_bbarT = SL(6); LAS unsigned char* s_VT = SL(7); LAS unsigned char* s_Akk = SL(8); LAS unsigned char* s_AbrT = SL(9);
    LAS unsigned char* s_nTAbrT = SL(13); LAS unsigned char* s_nTBbT = SL(14);
    LAS unsigned char* s_QyT = SL(6); LAS unsigned char* s_QsT = SL(9);
    LAS float* cum = (LAS float*)SL(10);
    LAS float* WCb = (LAS float*)SL(15);
#define PB(b) ((b) ? SL(0) : SL(10))
#define PTB(b) ((b) ? SL(1) : SL(11))
#define TB(b) ((b) ? SL(2) : SL(12))
    const int tw = wave & 3, rt = (tw >> 1) * 32, ct = (tw & 1) * 32;
#pragma unroll 1
    for (int unit = F.vcu; unit < 2048; unit += F.G) {
        const int bh = unit >> 6, c = unit & 63, bb = bh >> 3, hd = bh & 7;
        const size_t gbase = ((size_t)bb * SEQ + (size_t)c * 64) * RW + hd * 64;
        unsigned char* outp = P.ws + WS_BIG + (size_t)unit * CH_UNIT_BYTES;
        bf16_t* PsTp = (bf16_t*)outp; bf16_t* PyT = (bf16_t*)(outp + 8192); float* VQsT = (float*)(outp + 16384); float* VQyT = (float*)(outp + 32768);
        const int t = tid >> 3, j0 = (tid & 7) * 8;
        const size_t off = gbase + (size_t)t * RW + j0;
        const f32x4_t l0 = *(const f32x4_t*)(Lw + off), l1 = *(const f32x4_t*)(Lw + off + 4);
        const u32x4_t rr = *(const u32x4_t*)(Rb + off), kr = *(const u32x4_t*)(Kb + off), kkr = *(const u32x4_t*)(KKb + off), br = *(const u32x4_t*)(Bb + off), vr = *(const u32x4_t*)(Vb + off);
        *(LAS f32x4_t*)(cum + t * 68 + j0) = l0; *(LAS f32x4_t*)(cum + t * 68 + j0 + 4) = l1;
        __syncthreads();
        {
            float v8[8]; float run = 0.f;
#pragma unroll
            for (int q = 0; q < 8; ++q) { run += cum[(wave * 8 + q) * 68 + lane]; v8[q] = run; }
            LAS float* segt = (LAS float*)SL(12);
            segt[wave * 64 + lane] = run;
            __syncthreads();
            float offs = 0.f;
#pragma unroll
            for (int w2 = 0; w2 < 7; ++w2) offs += (w2 < wave) ? segt[w2 * 64 + lane] : 0.f;
#pragma unroll
            for (int q = 0; q < 8; ++q) cum[(wave * 8 + q) * 68 + lane] = v8[q] + offs;
        }
        __syncthreads();
        {
            const f32x4_t c0v = *(const LAS f32x4_t*)(cum + t * 68 + j0), c1v = *(const LAS f32x4_t*)(cum + t * 68 + j0 + 4);
            const f32x4_t e0v = *(const LAS f32x4_t*)(cum + 63 * 68 + j0), e1v = *(const LAS f32x4_t*)(cum + 63 * 68 + j0 + 4);
            u32x4_t o_khat, o_bhat, o_ktil, o_rtil, o_kbar;
#pragma unroll
            for (int e2 = 0; e2 < 4; ++e2) {
                float res[2][8];
#pragma unroll
                for (int q = 0; q < 2; ++q) {
                    const int e = 2 * e2 + q;
                    const float cu = e < 4 ? c0v[e & 3] : c1v[e & 3], lw = e < 4 ? l0[e & 3] : l1[e & 3], ce = e < 4 ? e0v[e & 3] : e1v[e & 3];
                    const float Wt = __builtin_amdgcn_exp2f(1.4426950408889634f * cu), Wp = __builtin_amdgcn_exp2f(1.4426950408889634f * (cu - lw));
                    const float iW = __builtin_amdgcn_exp2f(-1.4426950408889634f * cu), WCr = __builtin_amdgcn_exp2f(1.4426950408889634f * (ce - cu));
                    const float rv = q ? bfhi(rr[e2]) : bflo(rr[e2]), kv = q ? bfhi(kr[e2]) : bflo(kr[e2]), kkv = q ? bfhi(kkr[e2]) : bflo(kkr[e2]);
                    const float bv = q ? bfhi(br[e2]) : bflo(br[e2]);
                    res[q][0] = kv * iW; res[q][1] = bv * iW; res[q][2] = kkv * Wp; res[q][3] = rv * Wt; res[q][4] = kv * WCr; res[q][5] = bv * WCr;
                    if (t == 63) WCb[j0 + e] = __builtin_amdgcn_exp2f(1.4426950408889634f * ce);
                    *(LAS bf16_t*)(s_ktilT + (j0 + e) * CRS + t * 2) = (bf16_t)f2bf(res[q][2]);
                    *(LAS bf16_t*)(s_bbarT + (j0 + e) * CRS + t * 2) = (bf16_t)f2bf(res[q][5]);
                    *(LAS bf16_t*)(s_VT + (j0 + e) * CRS + t * 2) = (bf16_t)((q ? (vr[e2] >> 16) : (vr[e2] & 0xffffu)));
                }
                o_khat[e2] = pk2(res[0][0], res[1][0]); o_bhat[e2] = pk2(res[0][1], res[1][1]); o_ktil[e2] = pk2(res[0][2], res[1][2]);
                o_rtil[e2] = pk2(res[0][3], res[1][3]); o_kbar[e2] = pk2(res[0][4], res[1][4]);
            }
            *(LAS u32x4_t*)(s_khat + t * CRS + j0 * 2) = o_khat; *(LAS u32x4_t*)(s_bhat + t * CRS + j0 * 2) = o_bhat; *(LAS u32x4_t*)(s_ktil + t * CRS + j0 * 2) = o_ktil;
            *(LAS u32x4_t*)(s_rtil + t * CRS + j0 * 2) = o_rtil; *(LAS u32x4_t*)(s_kbar + t * CRS + j0 * 2) = o_kbar;
        }
        __syncthreads();
        const f32x16_t zero16 = {};
        f32x16_t Nt = tile_mm(s_bhat, rt, s_ktil, ct, zero16, r32, hi);
#pragma unroll
        for (int r = 0; r < 16; ++r) if (!(rt + crow(r, hi) < ct + r32)) Nt[r] = 0.f;
        f32x16_t keep = zero16;
        if (wave < 4) {
            f32x16_t a = tile_mm(s_khat, rt, s_ktil, ct, zero16, r32, hi);
#pragma unroll
            for (int r = 0; r < 16; ++r) if (!(rt + crow(r, hi) < ct + r32)) a[r] = 0.f;
            put_rm(s_Akk, a, rt, ct, r32, hi);
            keep = tile_mm(s_khat, rt, s_rtil, ct, zero16, r32, hi);
#pragma unroll
            for (int r = 0; r < 16; ++r) if (!(rt + crow(r, hi) <= ct + r32)) keep[r] = 0.f;
        } else {
            f32x16_t a = tile_mm(s_bhat, rt, s_rtil, ct, zero16, r32, hi);
#pragma unroll
            for (int r = 0; r < 16; ++r) if (!(rt + crow(r, hi) <= ct + r32)) a[r] = 0.f;
            put_tr(s_AbrT, a, rt, ct, r32, hi, 1.f);
        }
        f32x16_t M = Nt;
        if (wave < 4) {
#pragma unroll
            for (int r = 0; r < 16; ++r) M[r] = ((rt + crow(r, hi) == ct + r32) ? 1.f : 0.f) - Nt[r];
        }
        __syncthreads();
        if (wave < 4) put_rm(TB(0), M, rt, ct, r32, hi);
        else { put_rm(PB(0), M, rt, ct, r32, hi); put_tr(PTB(0), M, rt, ct, r32, hi, 1.f); }
        __syncthreads();
#pragma unroll
        for (int it = 0; it < 6; ++it) {
            const int cb = it & 1, nb = cb ^ 1;
            if (wave < 4) {
                if (it > 0) M = tile_mm(TB(cb ^ 1 ^ 1), rt, PTB(cb), ct, M, r32, hi);
                put_rm(TB(nb), M, rt, ct, r32, hi);
            } else if (it < 5) {
                M = tile_mm(PB(cb), rt, PTB(cb), ct, zero16, r32, hi);
                put_rm(PB(nb), M, rt, ct, r32, hi); put_tr(PTB(nb), M, rt, ct, r32, hi, 1.f);
            }
            __syncthreads();
        }
        {
            f32x16_t a = tile_mm(TB(0), rt, (wave < 4) ? s_AbrT : s_bbarT, ct, zero16, r32, hi);
            put_tr((wave < 4) ? s_nTAbrT : s_nTBbT, a, rt, ct, r32, hi, -1.f);
        }
        __syncthreads();
        if (wave < 4) {
            f32x16_t qy = tile_mm(s_Akk, rt, s_nTAbrT, ct, keep, r32, hi);
            f32x16_t cpy;
#pragma unroll
            for (int g = 0; g < 4; ++g) { const u32x2_t w = *(const LAS u32x2_t*)(s_rtil + (ct + r32) * CRS + (rt + 8 * g + 4 * hi) * 2);
                cpy[4 * g] = bflo(w.x); cpy[4 * g + 1] = bfhi(w.x); cpy[4 * g + 2] = bflo(w.y); cpy[4 * g + 3] = bfhi(w.y); }
            f32x16_t py = tile_mm(s_ktilT, rt, s_nTAbrT, ct, cpy, r32, hi);
#pragma unroll
            for (int g = 0; g < 4; ++g) { u32x2_t w; w.x = pk2(py[4 * g], py[4 * g + 1]); w.y = pk2(py[4 * g + 2], py[4 * g + 3]);
                *(u32x2_t*)(PyT + (size_t)(ct + r32) * 64 + rt + 8 * g + 4 * hi) = w; }
            __syncthreads();
            put_tr(s_QyT, qy, rt, ct, r32, hi, 1.f);
        } else {
            f32x16_t cq;
#pragma unroll
            for (int r = 0; r < 16; ++r) cq[r] = bf2f(*(const LAS bf16_t*)(s_kbar + (rt + crow(r, hi)) * CRS + (ct + r32) * 2));
            f32x16_t qs = tile_mm(s_Akk, rt, s_nTBbT, ct, cq, r32, hi);
            f32x16_t cps;
#pragma unroll
            for (int r = 0; r < 16; ++r) cps[r] = (rt + crow(r, hi) == ct + r32) ? WCb[ct + r32] : 0.f;
            f32x16_t ps = tile_mm(s_ktilT, rt, s_nTBbT, ct, cps, r32, hi);
#pragma unroll
            for (int g = 0; g < 4; ++g) { u32x2_t w; w.x = pk2(ps[4 * g], ps[4 * g + 1]); w.y = pk2(ps[4 * g + 2], ps[4 * g + 3]);
                *(u32x2_t*)(PsTp + (size_t)(ct + r32) * 64 + rt + 16 * (g >> 1) + 8 * hi + 4 * (g & 1)) = w; }
            __syncthreads();
            put_tr(s_QsT, qs, rt, ct, r32, hi, 1.f);
        }
        __syncthreads();
        {
            f32x16_t a = tile_mm((wave < 4) ? s_QyT : s_QsT, rt, s_VT, ct, zero16, r32, hi);
            if (wave < 4) {
#pragma unroll
                for (int r = 0; r < 16; ++r) VQyT[(size_t)(rt + crow(r, hi)) * 64 + ct + r32] = a[r];
            } else {
                u32x4_t w0, w1;
                w0.x = pk2(a[0], a[1]); w0.y = pk2(a[2], a[3]); w0.z = pk2(a[4], a[5]); w0.w = pk2(a[6], a[7]);
                w1.x = pk2(a[8], a[9]); w1.y = pk2(a[10], a[11]); w1.z = pk2(a[12], a[13]); w1.w = pk2(a[14], a[15]);
                u32x4_t* dq = (u32x4_t*)((unsigned char*)VQsT + (size_t)(tw * 64 + lane) * 32); dq[0] = w0; dq[1] = w1;
            }
        }
        __syncthreads();
    }
#undef SL
#undef PB
#undef PTB
#undef TB
}
constexpr int CHB_SLOT = 17408;
constexpr int CHB_NSLOT = 7;
constexpr int CHB_SOUT = CHB_NSLOT * CHB_SLOT;
__device__ __forceinline__ void ph_chunkB(const Frame& F, const Params& P) {
    const int lane = F.lane, r32 = lane & 31, hi = lane >> 5, wave = F.wave;
    if (F.vcu >= 32) {
        LAS float* scr = (LAS float*)(F.lds + F.wave * 16384);
        const int cw = (F.vcu - 32) * 8 + wave, NCW = (F.G - 32) * 8;
        conv_moe_all(P, cw, NCW, scr, lane);
        return;
    }
    const int bh = F.vcu;
    bf16_t* Sst = (bf16_t*)(P.ws + WS_Y) + (size_t)bh * 64 * 4096;
    const unsigned char* ub = P.ws + WS_BIG + (size_t)bh * 64 * CH_UNIT_BYTES;
    LAS unsigned char* L = F.lds;
    const int lw = wave - 2;
    u32x4_t ld[16];
#define CHB_GLOAD(c_) do { const unsigned char* up_ = ub + (size_t)(c_) * CH_UNIT_BYTES; \
        _Pragma("unroll") for (int q = 0; q < 8; ++q) ld[q] = *(const u32x4_t*)(up_ + (q * 64 + lane) * 16); \
        _Pragma("unroll") for (int q = 0; q < 8; ++q) ld[8 + q] = *(const u32x4_t*)(up_ + 16384 + (q * 64 + lane) * 16); } while (0)
#define CHB_LWRITE(slot_) do { LAS unsigned char* sl_ = L + (slot_) * CHB_SLOT; \
        _Pragma("unroll") for (int q = 0; q < 8; ++q) { const int p_ = q * 64 + lane; *(LAS u32x4_t*)(sl_ + (p_ >> 3) * CRS + (p_ & 7) * 16) = ld[q]; } \
        _Pragma("unroll") for (int q = 0; q < 8; ++q) *(LAS u32x4_t*)(sl_ + 9216 + (q * 64 + lane) * 16) = ld[8 + q]; } while (0)
    if (wave >= 2) { CHB_GLOAD(lw); CHB_LWRITE(lw); CHB_GLOAD(lw + 6); }
    f32x16_t X0 = {}, X1 = {};
    const int it = (wave & 1) * 32;
    int turn = 0, slot = 0;
#pragma unroll 1
    for (int c = 0; c < 64; ++c) {
        asm volatile("s_waitcnt lgkmcnt(0)" ::: "memory"); __builtin_amdgcn_s_barrier(); asm volatile("" ::: "memory");
        if (wave < 2) {
            const LAS unsigned char* sl = L + slot * CHB_SLOT;
            LAS unsigned char* so = L + CHB_SOUT + (c & 1) * CB;
            bf16x8_t xb[4];
#pragma unroll
            for (int s2 = 0; s2 < 2; ++s2) {
                u32x4_t w0, w1;
                w0.x = pk2(X0[8 * s2], X0[8 * s2 + 1]); w0.y = pk2(X0[8 * s2 + 2], X0[8 * s2 + 3]); w0.z = pk2(X0[8 * s2 + 4], X0[8 * s2 + 5]); w0.w = pk2(X0[8 * s2 + 6], X0[8 * s2 + 7]);
                w1.x = pk2(X1[8 * s2], X1[8 * s2 + 1]); w1.y = pk2(X1[8 * s2 + 2], X1[8 * s2 + 3]); w1.z = pk2(X1[8 * s2 + 4], X1[8 * s2 + 5]); w1.w = pk2(X1[8 * s2 + 6], X1[8 * s2 + 7]);
                xb[s2] = __builtin_bit_cast(bf16x8_t, w0); xb[2 + s2] = __builtin_bit_cast(bf16x8_t, w1);
                LAS unsigned char* row = so + (it + r32) * CRS;
                *(LAS u32x2_t*)(row + (16 * s2 + 4 * hi) * 2) = (u32x2_t){w0.x, w0.y}; *(LAS u32x2_t*)(row + (16 * s2 + 8 + 4 * hi) * 2) = (u32x2_t){w0.z, w0.w};
                *(LAS u32x2_t*)(row + (32 + 16 * s2 + 4 * hi) * 2) = (u32x2_t){w1.x, w1.y}; *(LAS u32x2_t*)(row + (32 + 16 * s2 + 8 + 4 * hi) * 2) = (u32x2_t){w1.z, w1.w};
            }
            f32x16_t Y0, Y1;
            {
                const LAS u32x4_t* f0 = (const LAS u32x4_t*)(sl + 9216 + ((0 * 2 + (wave & 1)) * 64 + lane) * 32);
                const LAS u32x4_t* f1 = (const LAS u32x4_t*)(sl + 9216 + ((1 * 2 + (wave & 1)) * 64 + lane) * 32);
                const u32x4_t a0 = f0[0], a1 = f0[1], b0 = f1[0], b1 = f1[1];
#pragma unroll
                for (int q = 0; q < 4; ++q) { Y0[2 * q] = bflo(a0[q]); Y0[2 * q + 1] = bfhi(a0[q]); Y0[8 + 2 * q] = bflo(a1[q]); Y0[8 + 2 * q + 1] = bfhi(a1[q]);
                                              Y1[2 * q] = bflo(b0[q]); Y1[2 * q + 1] = bfhi(b0[q]); Y1[8 + 2 * q] = bflo(b1[q]); Y1[8 + 2 * q + 1] = bfhi(b1[q]); }
            }
#pragma unroll
            for (int jt = 0; jt < 2; ++jt)
#pragma unroll
                for (int s2 = 0; s2 < 2; ++s2) {
                    const bf16x8_t a0 = *(const LAS bf16x8_t*)(sl + r32 * CRS + (jt * 32 + s2 * 16 + hi * 8) * 2);
                    const bf16x8_t a1 = *(const LAS bf16x8_t*)(sl + (32 + r32) * CRS + (jt * 32 + s2 * 16 + hi * 8) * 2);
                    Y0 = __builtin_amdgcn_mfma_f32_32x32x16_bf16(a0, xb[jt * 2 + s2], Y0, 0, 0, 0);
                    Y1 = __builtin_amdgcn_mfma_f32_32x32x16_bf16(a1, xb[jt * 2 + s2], Y1, 0, 0, 0);
                }
            X0 = Y0; X1 = Y1;
        } else if (lw == turn) {
            if (c + 6 < 64) CHB_LWRITE((slot == 0) ? 6 : slot - 1);
            if (c + 12 < 64) CHB_GLOAD(c + 12);
            if (c >= 1) {
                const LAS unsigned char* so = L + CHB_SOUT + ((c - 1) & 1) * CB;
                bf16_t* Sc = Sst + (size_t)(c - 1) * 4096;
#pragma unroll
                for (int q = 0; q < 8; ++q) { const int p_ = q * 64 + lane; *(u32x4_t*)((unsigned char*)Sc + p_ * 16) = *(const LAS u32x4_t*)(so + (p_ >> 3) * CRS + (p_ & 7) * 16); }
            }
        }
        turn = (turn == 5) ? 0 : turn + 1; slot = (slot == 6) ? 0 : slot + 1;
    }
    asm volatile("s_waitcnt lgkmcnt(0)" ::: "memory"); __builtin_amdgcn_s_barrier(); asm volatile("" ::: "memory");
    if (wave == 2) {
        const LAS unsigned char* so = L + CHB_SOUT + (63 & 1) * CB;
        bf16_t* Sc = Sst + (size_t)63 * 4096;
#pragma unroll
        for (int q = 0; q < 8; ++q) { const int p_ = q * 64 + lane; *(u32x4_t*)((unsigned char*)Sc + p_ * 16) = *(const LAS u32x4_t*)(so + (p_ >> 3) * CRS + (p_ & 7) * 16); }
    }
#undef CHB_GLOAD
#undef CHB_LWRITE
}
__device__ __forceinline__ void ph_chunkC(const Frame& F, const Params& P) {
    const bf16_t* Rb = (const bf16_t*)(P.ws + WS_R3 + 32 * MiB); const bf16_t* Kb = Rb + (size_t)NTOK * RW; const bf16_t* Vb = Rb + (size_t)NTOK * RW * 4;
    const bf16_t* Gb = (const bf16_t*)(P.ws + WS_G); bf16_t* XN = (bf16_t*)(P.ws + WS_XN);
    const float* ln_w = P.in[14]; const float* ln_b = P.in[15]; const float* r_k = P.in[13];
    const int gw = F.vcu * 8 + F.wave, NGW = F.G * 8, lane = F.lane, r32 = lane & 31, hi = lane >> 5;
#pragma unroll 1
    for (int job = gw; job < 4096; job += NGW) {
        const int unit = job >> 1, tt = (job & 1) * 32, bh = unit >> 6, c = unit & 63, bb = bh >> 3, hd = bh & 7;
        const unsigned char* up = P.ws + WS_BIG + (size_t)unit * CH_UNIT_BYTES;
        const bf16_t* PyT = (const bf16_t*)(up + 8192); const float* VQyT = (const float*)(up + 32768);
        const bf16_t* Sc = (const bf16_t*)(P.ws + WS_Y) + (size_t)unit * 4096;
        f32x16_t y0, y1;
#pragma unroll
        for (int r = 0; r < 16; ++r) { y0[r] = VQyT[(size_t)(tt + crow(r, hi)) * 64 + r32]; y1[r] = VQyT[(size_t)(tt + crow(r, hi)) * 64 + 32 + r32]; }
#pragma unroll
        for (int ks = 0; ks < 4; ++ks) {
            const bf16x8_t a = *(const bf16x8_t*)(PyT + (size_t)(tt + r32) * 64 + ks * 16 + hi * 8);
            const bf16x8_t b0 = *(const bf16x8_t*)(Sc + (size_t)r32 * 64 + ks * 16 + hi * 8);
            const bf16x8_t b1 = *(const bf16x8_t*)(Sc + (size_t)(32 + r32) * 64 + ks * 16 + hi * 8);
            y0 = __builtin_amdgcn_mfma_f32_32x32x16_bf16(a, b0, y0, 0, 0, 0); y1 = __builtin_amdgcn_mfma_f32_32x32x16_bf16(a, b1, y1, 0, 0, 0);
        }
        LAS float* yb = (LAS float*)(F.lds + F.wave * 8192);
#pragma unroll
        for (int r = 0; r < 16; ++r) { yb[crow(r, hi) * 64 + r32] = y0[r]; yb[crow(r, hi) * 64 + 32 + r32] = y1[r]; }
        asm volatile("s_waitcnt lgkmcnt(0)" ::: "memory");
        const int ch = hd * 64 + lane;
        const float lw = ln_w[ch], lb = ln_b[ch], rk = r_k[ch];
        const unsigned tok0 = (unsigned)(bb * SEQ + c * 64 + tt);
#pragma unroll 2
        for (int tl = 0; tl < 32; ++tl) {
            const unsigned o = (tok0 + tl) * RW + ch;
            const float yv = yb[tl * 64 + lane];
            const float rv = bf2f(Rb[o]), kv = bf2f(Kb[o]), vv = bf2f(Vb[o]), gv = bf2f(Gb[o]);
            const float mean = wsum(yv) * (1.f / 64.f), d = yv - mean;
            const float var = wsum(d * d) * (1.f / 64.f);
            const float bonus = wsum(rv * kv * rk);
            XN[(tok0 + tl) * D + ch] = (bf16_t)f2bf((d * rsqrtf(var + 64e-5f) * lw + lb + bonus * vv) * gv);
        }
        asm volatile("s_waitcnt lgkmcnt(0)" ::: "memory");
    }
}

constexpr int PLAN_OFF = MISC_OFF + 1024;
__device__ __forceinline__ void moe_plan(const unsigned* counts, unsigned char* lds_raw) {
    LAS int* plan = (LAS int*)((LAS unsigned char*)lds_raw + PLAN_OFF);
    if (threadIdx.x < NEXP) plan[threadIdx.x] = (int)__hip_atomic_load(counts + 64 * threadIdx.x, __ATOMIC_RELAXED, __HIP_MEMORY_SCOPE_AGENT);
    __syncthreads();
    if (threadIdx.x == 0) {
        int nb_total = 0;
        for (int e = 0; e < NEXP; ++e) {
            const int c = plan[e];
            plan[32 + e] = nb_total;
            const int nb = (c + MBLK - 1) / MBLK;
            for (int q = 0; q < nb; ++q) plan[65 + nb_total + q] = e;
            nb_total += nb;
        }
        plan[64] = nb_total;
    }
    __syncthreads();
}
__device__ __forceinline__ void ph_router(const Frame& F, const Params& P, int layer, int dummy) {
    const float* x = P.out; const float* gnorm = P.in[2] + layer * D;
    const float* w_group = P.in[26] + (size_t)layer * D * 4; const float* b_group = P.in[27] + layer * 4;
    const float* w_expert = P.in[28] + (size_t)layer * D * 32; const float* b_expert = P.in[29] + layer * 32;
    bf16_t* XN = (bf16_t*)(P.ws + WS_XN);
    int* eid = (int*)(P.ws + WS_MISC); int* posn = eid + NASSIGN;
    int* ltok = (int*)(P.ws + WS_G); float* lwt = (float*)(P.ws + WS_G + 2 * MiB);
    unsigned* counts = (unsigned*)(P.ws + WS_CTL) + (dummy ? 16384 : (layer ? CW_MOE1 : CW_MOE0));
    LAS float* Wl = (LAS float*)F.lds;
    for (int idx = F.tid; idx < 1024 * 36; idx += 512) { const int k = idx / 36, j = idx - k * 36; Wl[idx] = (j < 4) ? w_group[k * 4 + j] : w_expert[k * 32 + j - 4]; }
    __syncthreads();
    const int gw = F.vcu * 8 + F.wave, NGW = F.G * 8, lane = F.lane;
    for (int tok = gw; tok < NTOK; tok += NGW) {
        const float* xr = x + (size_t)tok * D + lane;
        float ss = 0.f;
#pragma unroll
        for (int m = 0; m < 16; ++m) { const float xv = xr[64 * m]; ss += xv * xv; }
        const float rs = rsqrtf(wsum(ss) * (1.f / D) + 1e-6f);
        float acc[36];
#pragma unroll
        for (int j = 0; j < 36; ++j) acc[j] = 0.f;
#pragma unroll 2
        for (int m = 0; m < 16; ++m) {
            const float hm = xr[64 * m] * rs * gnorm[lane + 64 * m];
            XN[(size_t)tok * D + lane + 64 * m] = (bf16_t)f2bf(hm);
            const LAS f32x4_t* wr = (const LAS f32x4_t*)(Wl + (lane + 64 * m) * 36);
#pragma unroll
            for (int q = 0; q < 9; ++q) { const f32x4_t w4 = wr[q]; acc[4 * q] += hm * w4.x; acc[4 * q + 1] += hm * w4.y; acc[4 * q + 2] += hm * w4.z; acc[4 * q + 3] += hm * w4.w; }
        }
        float lg[36];
#pragma unroll
        for (int j = 0; j < 36; ++j) lg[j] = wsum(acc[j]) + ((j < 4) ? b_group[j] : b_expert[j - 4]);
        int gi = 0; float gm = lg[0];
#pragma unroll
        for (int j = 1; j < 4; ++j) if (lg[j] > gm) { gm = lg[j]; gi = j; }
        float den = 0.f;
#pragma unroll
        for (int j = 0; j < 4; ++j) den += expf(lg[j] - gm);
        const float gwt = 1.f / den;
        float el[8];
#pragma unroll
        for (int j = 0; j < 8; ++j) el[j] = (gi == 0) ? lg[4 + j] : (gi == 1) ? lg[12 + j] : (gi == 2) ? lg[20 + j] : lg[28 + j];
        int i0 = 0; float v0 = el[0];
#pragma unroll
        for (int j = 1; j < 8; ++j) if (el[j] > v0) { v0 = el[j]; i0 = j; }
        int i1 = 0; float v1 = -INFINITY;
#pragma unroll
        for (int j = 0; j < 8; ++j) if (j != i0 && el[j] > v1) { v1 = el[j]; i1 = j; }
        const float e1 = expf(v1 - v0);
        const float p0 = 1.f / (1.f + e1), p1 = e1 / (1.f + e1);
        if (lane < 2) {
            const int e = gi * 8 + (lane ? i1 : i0);
            const unsigned pos = __hip_atomic_fetch_add(counts + 64 * e, 1u, __ATOMIC_RELAXED, __HIP_MEMORY_SCOPE_AGENT);
            eid[tok * 2 + lane] = e; posn[tok * 2 + lane] = (int)pos;
            if (!dummy) { ltok[e * 16384 + pos] = tok; lwt[e * 16384 + pos] = (lane ? p1 : p0) * gwt; }
        }
    }
    __syncthreads();
}

template <bool FINAL> __device__ __forceinline__ void ph_combine(const Frame& F, const Params& P, const float* gnorm) {
    float* x = P.out; const bf16_t* Yb = (const bf16_t*)(P.ws + WS_BIG); bf16_t* XN = (bf16_t*)(P.ws + WS_XN);
    const int* eid = (const int*)(P.ws + WS_MISC); const int* posn = eid + NASSIGN;
    const LAS int* plan = (const LAS int*)(F.lds + PLAN_OFF);
    const int gw = F.vcu * 8 + F.wave, NGW = F.G * 8, lane = F.lane;
    for (int tok = gw; tok < NTOK; tok += NGW) {
        const int s0 = plan[32 + eid[tok * 2]] * MBLK + posn[tok * 2], s1 = plan[32 + eid[tok * 2 + 1]] * MBLK + posn[tok * 2 + 1];
        f32x4_t* xr = (f32x4_t*)(x + (size_t)tok * D) + lane;
        const u32x2_t* y0 = (const u32x2_t*)(Yb + (size_t)s0 * D) + lane; const u32x2_t* y1 = (const u32x2_t*)(Yb + (size_t)s1 * D) + lane;
        f32x4_t v[4]; float ss = 0.f;
#pragma unroll
        for (int j = 0; j < 4; ++j) {
            v[j] = xr[64 * j]; const u32x2_t a = y0[64 * j], b = y1[64 * j];
            v[j].x += bflo(a.x) + bflo(b.x); v[j].y += bfhi(a.x) + bfhi(b.x); v[j].z += bflo(a.y) + bflo(b.y); v[j].w += bfhi(a.y) + bfhi(b.y);
            ss += (v[j].x * v[j].x + v[j].y * v[j].y) + (v[j].z * v[j].z + v[j].w * v[j].w);
        }
        const float rs = rsqrtf(wsum(ss) * (1.f / D) + 1e-6f);
        const f32x4_t* gr = (const f32x4_t*)gnorm + lane;
#pragma unroll
        for (int j = 0; j < 4; ++j) {
            const f32x4_t gg = gr[64 * j];
            if (FINAL) { f32x4_t o; o.x = v[j].x * rs * gg.x; o.y = v[j].y * rs * gg.y; o.z = v[j].z * rs * gg.z; o.w = v[j].w * rs * gg.w; xr[64 * j] = o; }
            else { xr[64 * j] = v[j]; u32x2_t o; o.x = pk2(v[j].x * rs * gg.x, v[j].y * rs * gg.y); o.y = pk2(v[j].z * rs * gg.z, v[j].w * rs * gg.w); ((u32x2_t*)(XN + (size_t)tok * D) + lane)[64 * j] = o; }
        }
    }
}

__device__ __forceinline__ void ph_attn_combine(const Frame& F, const Params& P) {
    const bf16_t* O = (const bf16_t*)(P.ws + WS_R3); bf16_t* XN = (bf16_t*)(P.ws + WS_XN);
    const float lambda_init = 0.35550906f;
    const int gw = F.vcu * 8 + F.wave, NGW = F.G * 8, lane = F.lane;
    const float la = wsum(P.in[20][lane] * P.in[21][lane]), lb = wsum(P.in[22][lane] * P.in[23][lane]);
    const float lam = expf(la) - expf(lb) + lambda_init;
    const float s0 = P.in[24][lane] * (1.f - lambda_init), s1 = P.in[24][64 + lane] * (1.f - lambda_init);
    for (int tok = gw; tok < NTOK; tok += NGW) {
        const bf16_t* Or = O + (size_t)tok * 2048;
#pragma unroll
        for (int h = 0; h < 8; ++h) {
            const float oa = bf2f(Or[(h * 4 + 0) * 64 + lane]) - lam * bf2f(Or[(h * 4 + 2) * 64 + lane]);
            const float ob = bf2f(Or[(h * 4 + 1) * 64 + lane]) - lam * bf2f(Or[(h * 4 + 3) * 64 + lane]);
            const float rs = rsqrtf(wsum(oa * oa + ob * ob) * (1.f / 128.f) + 1e-5f);
            XN[(size_t)tok * D + h * 128 + lane] = (bf16_t)f2bf(oa * rs * s0);
            XN[(size_t)tok * D + h * 128 + 64 + lane] = (bf16_t)f2bf(ob * rs * s1);
        }
    }
}

constexpr int N_PHASES = 20;
__device__ __forceinline__ Frame make_frame(unsigned char* lds_raw) {
    Frame F; F.lds = (LAS unsigned char*)lds_raw;
    F.tid = threadIdx.x; asm volatile("" : "+v"(F.tid));
    F.lane = F.tid & 63; F.wave = __builtin_amdgcn_readfirstlane(F.tid >> 6);
    F.G = gridDim.x; { const int bx = blockIdx.x; F.vcu = (F.G % 8 == 0) ? (bx % 8) * (F.G / 8) + bx / 8 : bx; }
    return F;
}
constexpr int PTBL_OFF = MISC_OFF + 256;
__device__ __forceinline__ Params load_params(unsigned char* lds_raw) {
    asm volatile("" ::: "memory");
    const LAS unsigned* t = (const LAS unsigned*)((LAS unsigned char*)lds_raw + PTBL_OFF);
    Params P;
#pragma unroll
    for (int i = 0; i < 33; ++i) { const unsigned lo = __builtin_amdgcn_readfirstlane(t[2 * i]), hi = __builtin_amdgcn_readfirstlane(t[2 * i + 1]); P.in[i] = (const float*)(const __attribute__((address_space(1))) float*)(((unsigned long long)hi << 32) | lo); }
    { const unsigned lo = __builtin_amdgcn_readfirstlane(t[66]), hi = __builtin_amdgcn_readfirstlane(t[67]); P.out = (float*)(__attribute__((address_space(1))) float*)(((unsigned long long)hi << 32) | lo); }
    { const unsigned lo = __builtin_amdgcn_readfirstlane(t[68]), hi = __builtin_amdgcn_readfirstlane(t[69]); P.ws = (unsigned char*)(__attribute__((address_space(1))) unsigned char*)(((unsigned long long)hi << 32) | lo); }
    P.ph_lo = (int)__builtin_amdgcn_readfirstlane(t[70]); P.ph_hi = (int)__builtin_amdgcn_readfirstlane(t[71]);
    return P;
}
__global__ void __launch_bounds__(512, 2) mega(Params Parg) {
    extern __shared__ __attribute__((aligned(16))) unsigned char lds_raw[];
    {
        volatile LAS unsigned* MISC = (volatile LAS unsigned*)((LAS unsigned char*)lds_raw + MISC_OFF);
        if (threadIdx.x < 32) MISC[threadIdx.x] = 0u;
        const unsigned* ka = (const unsigned*)__builtin_amdgcn_kernarg_segment_ptr();
        if (threadIdx.x < 72) ((LAS unsigned*)((LAS unsigned char*)lds_raw + PTBL_OFF))[threadIdx.x] = ka[threadIdx.x];
        __syncthreads();
    }
    const int ph_lo = load_params(lds_raw).ph_lo, ph_hi = load_params(lds_raw).ph_hi;
    if (ph_hi - ph_lo > 1) { (void)xcd_barrier_post((unsigned*)(load_params(lds_raw).ws + WS_CTL) + CW_BAR, (volatile LAS unsigned*)((LAS unsigned char*)lds_raw + MISC_OFF) + 8); }
#define IN(k) (ph_lo <= (k) && (k) < ph_hi)
#define SEAM2(k, kn) do { if (IN(k) && IN(kn)) { XcdBarrier bar_; bar_.bar = (unsigned*)(load_params(lds_raw).ws + WS_CTL) + CW_BAR; bar_.x = xb_xcc_id(); \
        bar_.st = (volatile LAS unsigned*)((LAS unsigned char*)lds_raw + MISC_OFF) + 8; xcd_barrier(bar_); } } while (0)
#define SEAM(k) SEAM2(k, (k) + 1)
#ifndef PROBE_MASK
#define PROBE_MASK 0
#endif
#define REP(k) ((PROBE_MASK >> (k)) & 1)
#define FORCE_BAR do { XcdBarrier bar_; bar_.bar = (unsigned*)(load_params(lds_raw).ws + WS_CTL) + CW_BAR; bar_.x = xb_xcc_id(); \
        bar_.st = (volatile LAS unsigned*)((LAS unsigned char*)lds_raw + MISC_OFF) + 8; xcd_barrier(bar_); } while (0)
#define WSB(off) ((bf16_t*)(P.ws + (off)))
    if (IN(0)) for (int rep_ = 0; rep_ <= REP(0); ++rep_) { if (rep_) FORCE_BAR; const Params P = load_params(lds_raw); const Frame F = make_frame(lds_raw); ph_prologue(F, P); }
    SEAM(0);
    if (IN(1)) for (int rep_ = 0; rep_ <= REP(1); ++rep_) { if (rep_) FORCE_BAR; const Params P = load_params(lds_raw); pg8::Gemm g{WSB(WS_XN), WSB(WS_WIN), NTOK, INW, D, 0}; pg8::EpiBf16Plain E{WSB(WS_BIG), INW, 0}; pg8::PlainOrder S{}; S.init(NTOK, INW, (int)gridDim.x, (int)blockIdx.x);
        pg8::gemm_phase<pg8::EpiBf16Plain, pg8::PlainOrder, true, true>((LAS unsigned char*)lds_raw, g, S, E); }
    SEAM(1);
    if (IN(2)) for (int rep_ = 0; rep_ <= REP(2); ++rep_) { if (rep_) FORCE_BAR; const Params P = load_params(lds_raw); const Frame F = make_frame(lds_raw); ph_prep(F, P); }
    SEAM(2);
    if (IN(3)) for (int rep_ = 0; rep_ <= REP(3); ++rep_) { if (rep_) FORCE_BAR; const Params P = load_params(lds_raw); const Frame F = make_frame(lds_raw); ph_chunkA(F, P); }
    SEAM(3);
    if (IN(4)) for (int rep_ = 0; rep_ <= REP(4); ++rep_) { if (rep_) FORCE_BAR; const Params P = load_params(lds_raw); const Frame F = make_frame(lds_raw); ph_chunkB(F, P); FORCE_BAR; asm volatile("" ::: "memory"); { const Params P2 = load_params(lds_raw); const Frame F2 = make_frame(lds_raw); ph_chunkC(F2, P2); } }
    SEAM(4);
    if (IN(5)) for (int rep_ = 0; rep_ <= REP(5); ++rep_) { if (rep_) FORCE_BAR; const Params P = load_params(lds_raw); pg8::Gemm g{WSB(WS_XN), WSB(WS_WOUT), NTOK, D, D, 0}; pg8::EpiResF32 E{P.in[0], P.out, D, 0}; pg8::PlainOrder S{}; S.init(NTOK, D, (int)gridDim.x, (int)blockIdx.x);
        pg8::gemm_phase<pg8::EpiResF32, pg8::PlainOrder, true, true>((LAS unsigned char*)lds_raw, g, S, E); }
    SEAM(5);
#define MOE_PHASES(layer, pb) \
    if (IN(pb)) for (int rep_ = 0; rep_ <= REP(pb); ++rep_) { if (rep_) FORCE_BAR; const Params P = load_params(lds_raw); const Frame F = make_frame(lds_raw); ph_router(F, P, layer, rep_ < REP(pb)); } \
    SEAM2(pb, (pb) + 2); \
    if (IN((pb) + 2)) for (int rep_ = 0; rep_ <= REP((pb) + 2); ++rep_) { if (rep_) FORCE_BAR; const Params P = load_params(lds_raw); \
        moe_plan((const unsigned*)(P.ws + WS_CTL) + ((layer) ? CW_MOE1 : CW_MOE0), lds_raw); \
        pg8::Gemm g{WSB(WS_XN), WSB(WS_W1T) + (size_t)(layer) * NEXP * 1024 * D, PMAX, 1024, D, 0}; pg8::EpiSwiglu E{WSB(WS_R3) + (size_t)40 * MiB}; \
        pg8::GroupedOrderT<true> S{(const LAS int*)((LAS unsigned char*)lds_raw + PLAN_OFF), (const int*)(P.ws + WS_G), (size_t)1024 * D * 2, 4, 0, 0, 0}; S.bind((int)gridDim.x, (int)blockIdx.x); \
        pg8::gemm_phase<pg8::EpiSwiglu, pg8::GroupedOrderT<true>, true, true>((LAS unsigned char*)lds_raw, g, S, E); } \
    SEAM((pb) + 2); \
    if (IN((pb) + 3)) for (int rep_ = 0; rep_ <= REP((pb) + 3); ++rep_) { if (rep_) FORCE_BAR; const Params P = load_params(lds_raw); \
        moe_plan((const unsigned*)(P.ws + WS_CTL) + ((layer) ? CW_MOE1 : CW_MOE0), lds_raw); \
        pg8::Gemm g{WSB(WS_R3) + (size_t)40 * MiB, WSB(WS_W2T) + (size_t)(layer) * NEXP * D * MH, PMAX, D, MH, 0}; \
        pg8::EpiScaleBf16 E{WSB(WS_BIG), (const float*)(P.ws + WS_G + 2 * MiB), D, 0}; \
        pg8::GroupedOrderT<false> S{(const LAS int*)((LAS unsigned char*)lds_raw + PLAN_OFF), nullptr, (size_t)D * MH * 2, 4, 0, 0, 0}; S.bind((int)gridDim.x, (int)blockIdx.x); \
        pg8::gemm_phase<pg8::EpiScaleBf16, pg8::GroupedOrderT<false>, true, true>((LAS unsigned char*)lds_raw, g, S, E); } \
    SEAM((pb) + 3);

    MOE_PHASES(0, 6)
    if (IN(10)) for (int rep_ = 0; rep_ <= REP(10); ++rep_) { if (rep_) FORCE_BAR; const Params P = load_params(lds_raw); moe_plan((const unsigned*)(P.ws + WS_CTL) + CW_MOE0, lds_raw); const Frame F = make_frame(lds_raw); ph_combine<false>(F, P, P.in[1] + D); }
    SEAM(10);
    if (IN(11)) for (int rep_ = 0; rep_ <= REP(11); ++rep_) { if (rep_) FORCE_BAR; const Params P = load_params(lds_raw); pg8::Gemm g{WSB(WS_XN), WSB(WS_WQKV), NTOK, QKVW, D, 0}; pg8::EpiQKV E{WSB(WS_BIG), (const float*)(P.ws + WS_SMALLW + 393216), attn_body::C2, 0};
        pg8::PlainOrder S{}; S.init(NTOK, QKVW, (int)gridDim.x, (int)blockIdx.x);
        pg8::gemm_phase<pg8::EpiQKV, pg8::PlainOrder, true, true>((LAS unsigned char*)lds_raw, g, S, E); }
    SEAM(11);
    if (IN(12)) for (int rep_ = 0; rep_ <= REP(12); ++rep_) { if (rep_) FORCE_BAR; const Params P = load_params(lds_raw); const attn_body::AttnTensors AT{(const attn_body::bf16*)WSB(WS_BIG), (const attn_body::bf16*)(WSB(WS_BIG) + 1024), (const attn_body::bf16*)(WSB(WS_BIG) + 2048), (attn_body::bf16*)WSB(WS_R3)};
        const attn_body::StaticOrder S((int)gridDim.x, (int)blockIdx.x);
        attn_body::attn_phase<attn_body::StaticOrder>((char*)lds_raw, AT, S); }
    SEAM(12);
    if (IN(13)) for (int rep_ = 0; rep_ <= REP(13); ++rep_) { if (rep_) FORCE_BAR; const Params P = load_params(lds_raw); const Frame F = make_frame(lds_raw); ph_attn_combine(F, P); }
    SEAM(13);
    if (IN(14)) for (int rep_ = 0; rep_ <= REP(14); ++rep_) { if (rep_) FORCE_BAR; const Params P = load_params(lds_raw); pg8::Gemm g{WSB(WS_XN), WSB(WS_CWOUT), NTOK, D, D, 0}; pg8::EpiResF32 E{P.out, P.out, D, 0}; pg8::PlainOrder S{}; S.init(NTOK, D, (int)gridDim.x, (int)blockIdx.x);
        pg8::gemm_phase<pg8::EpiResF32, pg8::PlainOrder, true, true>((LAS unsigned char*)lds_raw, g, S, E); }
    SEAM(14);
    MOE_PHASES(1, 15)
    if (IN(19)) for (int rep_ = 0; rep_ <= REP(19); ++rep_) { if (rep_) FORCE_BAR; const Params P = load_params(lds_raw); moe_plan((const unsigned*)(P.ws + WS_CTL) + CW_MOE1, lds_raw); const Frame F = make_frame(lds_raw); ph_combine<true>(F, P, P.in[3]); }
#undef MOE_PHASES
#undef IN
#undef SEAM
#undef WSB
}

#ifdef DBG_STAGES
__global__ void __launch_bounds__(512, 2) dbgA(Params P) { extern __shared__ __attribute__((aligned(16))) unsigned char l[]; const Frame F = make_frame(l); ph_chunkA(F, P); }
__global__ void __launch_bounds__(512, 2) dbgB(Params P) { extern __shared__ __attribute__((aligned(16))) unsigned char l[]; const Frame F = make_frame(l); ph_chunkB(F, P); }
__global__ void __launch_bounds__(512, 2) dbgC(Params P) { extern __shared__ __attribute__((aligned(16))) unsigned char l[]; const Frame F = make_frame(l); ph_chunkC(F, P); }
__global__ void __launch_bounds__(512, 2) dbgPrep(Params P) { extern __shared__ __attribute__((aligned(16))) unsigned char l[]; const Frame F = make_frame(l); ph_prep(F, P); }
__global__ void __launch_bounds__(512, 2) dbgRouter(Params P) { extern __shared__ __attribute__((aligned(16))) unsigned char l[]; const Frame F = make_frame(l); ph_router(F, P, 1, 0); }
#endif
}

extern "C" void kernel_launch(void* const* d_in, const int* in_sizes, int n_in, void* d_out, int out_size, void* d_ws, size_t ws_size,
                              hipStream_t stream) {
    static int grid = 0;
    if (grid == 0) {
        (void)hipFuncSetAttribute((const void*)mega, hipFuncAttributeMaxDynamicSharedMemorySize, LDS_BYTES);
        int dev = 0, cus = 0, per_cu = 0;
        (void)hipGetDevice(&dev); (void)hipDeviceGetAttribute(&cus, hipDeviceAttributeMultiprocessorCount, dev);
        (void)hipOccupancyMaxActiveBlocksPerMultiprocessor(&per_cu, (const void*)mega, 512, LDS_BYTES);
        (void)hipGetLastError();
        grid = (per_cu >= 1 && cus > 0) ? cus : 256;
    }
    (void)hipMemsetAsync((char*)d_ws + WS_CTL, 0, CTL_ZERO_BYTES, stream);
    Params P{};
    for (int i = 0; i < 33; ++i) P.in[i] = (const float*)d_in[i];
    P.out = (float*)d_out; P.ws = (unsigned char*)d_ws;
#if MK_PER_PHASE
    for (int ph = 0; ph < N_PHASES; ++ph) { P.ph_lo = ph; P.ph_hi = ph + 1; hipLaunchKernelGGL(mega, dim3(grid), dim3(512), LDS_BYTES, stream, P); }
#else
    P.ph_lo = 0; P.ph_hi = N_PHASES;
    hipLaunchKernelGGL(mega, dim3(grid), dim3(512), LDS_BYTES, stream, P);
#endif
}
```
